# Optimizing an MI355X kernel written in HIP

```python
import jax, jax.numpy as jnp
from jax import lax
import numpy as np

D_MODEL = 1024
BATCH = 16
SEQ = 2048
DEPTH = 2

N_MIXERS = 2
GRID_W = 64
RMS_EPS = 1e-6
GN_EPS = 1e-6
ROPE_THETA = 10000.0

RET_HEADS = 4
RET_QK_DIM = D_MODEL // RET_HEADS
RET_V_DIM = 2 * RET_QK_DIM
RET_CHUNK = 128
RET_QK_W = RET_HEADS * RET_QK_DIM
RET_V_W = RET_HEADS * RET_V_DIM
RET_IN_W = 2 * RET_QK_W + 2 * RET_V_W

ATTN_HEAD_DIM = 128
ATTN_Q_HEADS = D_MODEL // ATTN_HEAD_DIM
ATTN_KV_HEADS = 2
ATTN_GROUP = ATTN_Q_HEADS // ATTN_KV_HEADS
ATTN_IN_W = (ATTN_Q_HEADS + 2 * ATTN_KV_HEADS) * ATTN_HEAD_DIM
Q_BLOCK = 128

D_FF = 4 * D_MODEL

N_RET_LAYERS = (DEPTH + 1) // 2
N_ATTN_LAYERS = DEPTH // 2

kernel_name = "hybrid_retention_gqa_axial_encoder"


def rms_norm(x, g):
    xf = x.astype(jnp.float32)
    y = xf * lax.rsqrt(jnp.mean(xf * xf, axis=-1, keepdims=True) + RMS_EPS)
    return (y * g.astype(jnp.float32)).astype(x.dtype)


def axial_rope_tables(seq, rot_dim):
    rows = seq // GRID_W
    row = jnp.broadcast_to(jnp.arange(rows, dtype=jnp.float32)[:, None], (rows, GRID_W)).reshape(seq)
    col = jnp.broadcast_to(jnp.arange(GRID_W, dtype=jnp.float32)[None, :], (rows, GRID_W)).reshape(seq)
    per_axis = rot_dim // 2
    n_freq = per_axis // 2
    inv_freq = ROPE_THETA ** (-jnp.arange(n_freq, dtype=jnp.float32) * 2.0 / per_axis)
    ang = jnp.concatenate([row[:, None] * inv_freq[None, :], col[:, None] * inv_freq[None, :]], axis=-1)
    return jnp.cos(ang), jnp.sin(ang)


def apply_rope(x, cos, sin):
    xf = x.astype(jnp.float32)
    half = xf.shape[-1] // 2
    x1, x2 = xf[..., :half], xf[..., half:]
    out = jnp.concatenate([x1 * cos - x2 * sin, x1 * sin + x2 * cos], axis=-1)
    return out.astype(x.dtype)


def chunkwise_retention(q, k, v, log_gamma, include_diag):
    B, H, S, dk = q.shape
    dv = v.shape[-1]
    C = RET_CHUNK
    N = S // C
    idx = jnp.arange(C, dtype=jnp.float32)
    lg = log_gamma.astype(jnp.float32)
    diff = idx[:, None] - idx[None, :]
    mask = (diff >= 0) if include_diag else (diff > 0)
    decay_intra = jnp.where(mask[None], jnp.exp(lg[:, None, None] * jnp.where(mask, diff, 0.0)[None]), 0.0)
    xi = jnp.exp(lg[:, None] * (idx[None, :] + 1.0))
    zeta = jnp.exp(lg[:, None] * (C - 1.0 - idx[None, :]))
    gamma_c = jnp.exp(lg * C)

    def to_chunks(t):
        return t.reshape(B, H, N, C, t.shape[-1]).transpose(2, 0, 1, 3, 4)

    def step(state, xs):
        qb, kb, vb = xs
        scores = jnp.einsum('bhid,bhjd->bhij', qb, kb) * decay_intra[None]
        intra = jnp.einsum('bhij,bhjv->bhiv', scores, vb)
        inter = jnp.einsum('bhid,bhdv->bhiv', qb, state) * xi[None, :, :, None]
        new_state = state * gamma_c[None, :, None, None] + jnp.einsum(
            'bhjd,bhjv->bhdv', kb * zeta[None, :, :, None], vb)
        return new_state, intra + inter

    state0 = jnp.zeros((B, H, dk, dv), jnp.float32)
    _, ys = lax.scan(step, state0, (to_chunks(q), to_chunks(k), to_chunks(v)))
    return ys.transpose(1, 2, 0, 3, 4).reshape(B, H, S, dv)


def retention_mixer(h, w_in, w_out, decay_fwd, decay_bwd, cos, sin):
    B, S, _ = h.shape
    proj = h @ w_in
    q, k, v, g = jnp.split(proj, [RET_QK_W, 2 * RET_QK_W, 2 * RET_QK_W + RET_V_W], axis=-1)
    q = q.reshape(B, S, RET_HEADS, RET_QK_DIM).transpose(0, 2, 1, 3)
    k = k.reshape(B, S, RET_HEADS, RET_QK_DIM).transpose(0, 2, 1, 3)
    v = v.reshape(B, S, RET_HEADS, RET_V_DIM).transpose(0, 2, 1, 3).astype(jnp.float32)
    q = apply_rope(q, cos, sin).astype(jnp.float32)
    k = apply_rope(k, cos, sin).astype(jnp.float32) * (RET_QK_DIM ** -0.5)
    log_gf = -jnp.exp(decay_fwd.astype(jnp.float32))
    log_gb = -jnp.exp(decay_bwd.astype(jnp.float32))
    y_fwd = chunkwise_retention(q, k, v, log_gf, include_diag=True)
    y_bwd = jnp.flip(chunkwise_retention(jnp.flip(q, 2), jnp.flip(k, 2), jnp.flip(v, 2),
                                         log_gb, include_diag=False), 2)
    y = y_fwd + y_bwd
    mu = jnp.mean(y, axis=-1, keepdims=True)
    var = jnp.mean(jnp.square(y - mu), axis=-1, keepdims=True)
    y = (y - mu) * lax.rsqrt(var + GN_EPS)
    y = y.transpose(0, 2, 1, 3).reshape(B, S, RET_V_W).astype(h.dtype)
    return (jax.nn.silu(g) * y) @ w_out


def attention_mixer(h, w_in, w_out, q_gain, k_gain, cos, sin):
    B, S, _ = h.shape
    proj = h @ w_in
    q_w = ATTN_Q_HEADS * ATTN_HEAD_DIM
    kv_w = ATTN_KV_HEADS * ATTN_HEAD_DIM
    q, k, v = jnp.split(proj, [q_w, q_w + kv_w], axis=-1)
    q = q.reshape(B, S, ATTN_KV_HEADS, ATTN_GROUP, ATTN_HEAD_DIM).transpose(0, 2, 3, 1, 4)
    k = k.reshape(B, S, ATTN_KV_HEADS, ATTN_HEAD_DIM).transpose(0, 2, 1, 3)
    v = v.reshape(B, S, ATTN_KV_HEADS, ATTN_HEAD_DIM).transpose(0, 2, 1, 3)
    q = apply_rope(rms_norm(q, q_gain), cos, sin) * (ATTN_HEAD_DIM ** -0.5)
    k = apply_rope(rms_norm(k, k_gain), cos, sin)
    nb = S // Q_BLOCK
    qb = q.reshape(B, ATTN_KV_HEADS, ATTN_GROUP, nb, Q_BLOCK, ATTN_HEAD_DIM).transpose(3, 0, 1, 2, 4, 5)

    def one_block(q_blk):
        s = jnp.einsum('bkgqd,bksd->bkgqs', q_blk, k).astype(jnp.float32)
        p = jax.nn.softmax(s, axis=-1).astype(v.dtype)
        return jnp.einsum('bkgqs,bksd->bkgqd', p, v)

    o = lax.map(one_block, qb)
    o = o.transpose(1, 0, 4, 2, 3, 5).reshape(B, S, D_MODEL)
    return o @ w_out


def sq_relu_mlp(h, w1, w2):
    return jnp.square(jax.nn.relu(h @ w1)) @ w2


def setup_inputs(seed: int = 0) -> dict:
    key = jax.random.key(seed)
    ks = jax.random.split(key, 16)
    f32 = jnp.float32

    def w(k, shape, fan_in):
        return jax.random.normal(k, shape, f32) * (fan_in ** -0.5)

    def gain(k, shape):
        return 1.0 + 0.05 * jax.random.normal(k, shape, f32)

    base = jnp.log(-jnp.log(1.0 - 2.0 ** (-5.0 - jnp.arange(RET_HEADS, dtype=f32))))
    return {
        "x": jax.random.normal(ks[0], (BATCH, SEQ, D_MODEL), f32),
        "norm_mix": gain(ks[1], (DEPTH, D_MODEL)),
        "norm_mlp": gain(ks[2], (DEPTH, D_MODEL)),
        "mlp_w1": w(ks[3], (DEPTH, D_MODEL, D_FF), D_MODEL),
        "mlp_w2": w(ks[4], (DEPTH, D_FF, D_MODEL), D_FF),
        "ret_w_in": w(ks[5], (N_RET_LAYERS, D_MODEL, RET_IN_W), D_MODEL),
        "ret_w_out": w(ks[6], (N_RET_LAYERS, RET_V_W, D_MODEL), RET_V_W),
        "ret_decay_fwd": base[None, :] + 0.05 * jax.random.normal(ks[7], (N_RET_LAYERS, RET_HEADS), f32),
        "ret_decay_bwd": base[None, :] + 0.05 * jax.random.normal(ks[8], (N_RET_LAYERS, RET_HEADS), f32),
        "attn_w_in": w(ks[9], (N_ATTN_LAYERS, D_MODEL, ATTN_IN_W), D_MODEL),
        "attn_w_out": w(ks[10], (N_ATTN_LAYERS, D_MODEL, D_MODEL), D_MODEL),
        "attn_q_norm": gain(ks[11], (N_ATTN_LAYERS, ATTN_HEAD_DIM)),
        "attn_k_norm": gain(ks[12], (N_ATTN_LAYERS, ATTN_HEAD_DIM)),
        "final_norm": gain(ks[13], (D_MODEL,)),
    }


def reference(x, norm_mix, norm_mlp, mlp_w1, mlp_w2, ret_w_in, ret_w_out, ret_decay_fwd,
              ret_decay_bwd, attn_w_in, attn_w_out, attn_q_norm, attn_k_norm, final_norm):
    S = x.shape[1]
    cos_r, sin_r = axial_rope_tables(S, RET_QK_DIM)
    cos_a, sin_a = axial_rope_tables(S, ATTN_HEAD_DIM)
    h = x
    for i in range(DEPTH):
        u = rms_norm(h, norm_mix[i])
        j = i // N_MIXERS
        if i % N_MIXERS == 0:
            h = h + retention_mixer(u, ret_w_in[j], ret_w_out[j], ret_decay_fwd[j],
                                    ret_decay_bwd[j], cos_r, sin_r)
        else:
            h = h + attention_mixer(u, attn_w_in[j], attn_w_out[j], attn_q_norm[j],
                                    attn_k_norm[j], cos_a, sin_a)
        u = rms_norm(h, norm_mlp[i])
        h = h + sq_relu_mlp(u, mlp_w1[i], mlp_w2[i])
    return rms_norm(h, final_norm)
```

```cpp
#include <hip/hip_runtime.h>
#include <hip/hip_bf16.h>
#include <hip/hip_cooperative_groups.h>
#include <cstdio>
#include <cstdint>
namespace cg = cooperative_groups;

#define LAS __attribute__((address_space(3)))
#define GAS __attribute__((address_space(1)))
typedef unsigned short bf16_t;
typedef short bf16x8 __attribute__((ext_vector_type(8)));
typedef float f32x4 __attribute__((ext_vector_type(4)));
typedef float f32x2 __attribute__((ext_vector_type(2)));
typedef unsigned u32x4 __attribute__((ext_vector_type(4)));
typedef unsigned u32x2 __attribute__((ext_vector_type(2)));

constexpr int NB = 16, SEQ = 2048, DM = 1024, MTOK = NB * SEQ;
constexpr int HM = MTOK / 2;
constexpr float RMS_EPS = 1e-6f, GN_EPS = 1e-6f;
constexpr float LOG2E = 1.4426950408889634f;

__device__ __forceinline__ int lane_id() { return (int)__builtin_amdgcn_mbcnt_hi(~0u, __builtin_amdgcn_mbcnt_lo(~0u, 0u)); }
namespace pg8 {
constexpr int BM = 256, BK = 64, HALF = 128, HTB = HALF * BK * 2, STAGE_BYTES = 8 * HTB, NXCD = 8, WGM = 8;
__host__ __device__ __forceinline__ int lds_byte(int r, int c) { const int st = (r >> 4) * 2 + (c >> 5), rr = r & 15, cc = c & 31, ob = rr * 64 + cc * 2; return st * 1024 + (ob ^ (((ob >> 9) & 1) << 5)); }
__host__ __device__ __forceinline__ void stage_rc(int b, int& R, int& C) { const int st = b / 1024, sb = b % 1024, swz = sb ^ (((sb >> 9) & 1) << 5); R = (st >> 1) * 16 + swz / 64; C = (st & 1) * 32 + (swz % 64) / 2; }
__host__ __device__ __forceinline__ int perm32(int rho) { const int n = rho >> 4, i = rho & 15; return 8 * (i >> 2) + 4 * n + (i & 3); }

struct Unit { const char* a; const char* b; int pm, pn, aux; };

__device__ __forceinline__ void tile_of(int L, int nM, int nN, int& pm, int& pn) {
    const int nwg = nM * nN; int wgid = L; { const int q = nwg / NXCD, r = nwg % NXCD, xcd = wgid % NXCD, off = wgid / NXCD; wgid = (xcd < r ? xcd * (q + 1) : r * (q + 1) + (xcd - r) * q) + off; }
    const int nig = WGM * nN, gid = wgid / nig, fm = gid * WGM, gsz = (nM - fm) < WGM ? (nM - fm) : WGM;
    pm = fm + ((wgid % nig) % gsz); pn = (wgid % nig) / gsz;
}

__device__ __forceinline__ unsigned cvt_pk_bf16(float lo, float hi) { unsigned r; asm volatile("v_cvt_pk_bf16_f32 %0, %1, %2" : "=v"(r) : "v"(lo), "v"(hi)); return r; }
__device__ __forceinline__ float bf_lo(unsigned w) { return __uint_as_float(w << 16); }
__device__ __forceinline__ float bf_hi(unsigned w) { return __uint_as_float(w & 0xffff0000u); }

typedef f32x4 Acc[2][2][4][2];

template <class Epi, class Sched>
__device__ __forceinline__ void gemm_phase(LAS unsigned char* lds, int wave_id, const Sched& S, const Epi& E, int stagger = 0) {
    for (int i = 0; i < stagger; ++i) __builtin_amdgcn_s_sleep(127);
    int lane_ = lane_id(); asm volatile("" : "+v"(lane_));
    const int wid = wave_id, lane = lane_, tid = wid * 64 + lane, wr = wid >> 2, wc = wid & 3, fr = lane & 15, fq = lane >> 4;
    constexpr int LDA = Sched::LDA, LDB = Sched::LDB, nt = Sched::NT;
    unsigned voffA[2], voffB[2];
#pragma unroll
    for (int i = 0; i < 2; ++i) { int R, C; stage_rc(tid * 16 + i * 8192, R, C); const int Rb = (R & ~31) + perm32(R & 31);
        voffA[i] = (unsigned)(R * LDA + C) * 2u; voffB[i] = (unsigned)(Rb * LDB + C) * 2u; }
    constexpr size_t kstep = (size_t)(BK * 2);
    constexpr size_t hstepA = (size_t)HALF * LDA * 2, hstepB = (size_t)HALF * LDB * 2;
    const unsigned ldsw = (unsigned)wid * 1024u;
    const int aoff = lds_byte(wr * 64 + fr, fq * 8), boff = lds_byte(wc * 32 + fr, fq * 8);
#define PG8_SA(b, h) (((b) * 2 + (h)) * HTB)
#define PG8_SB(b, h) ((4 + (b) * 2 + (h)) * HTB)
#define PG8_STAGE(bufoff, gbase, voff) do { _Pragma("unroll") for (int _i = 0; _i < 2; ++_i) \
        __builtin_amdgcn_global_load_lds((const unsigned*)((const char*)(gbase) + (voff)[_i]), (LAS unsigned*)(lds + (bufoff) + ldsw + _i * 8192), 16, 0, 0); } while (0)
#define PG8_LDA(dst, b, h) do { _Pragma("unroll") for (int m = 0; m < 4; ++m) _Pragma("unroll") for (int k = 0; k < 2; ++k) dst[m][k] = *(const LAS bf16x8*)(lds + PG8_SA(b, h) + aoff + m * 2048 + k * 1024); } while (0)
#define PG8_LDB(dst, b, h) do { _Pragma("unroll") for (int n = 0; n < 2; ++n) _Pragma("unroll") for (int k = 0; k < 2; ++k) dst[n][k] = *(const LAS bf16x8*)(lds + PG8_SB(b, h) + boff + n * 2048 + k * 1024); } while (0)
#define PG8_MMA(ai, bj, At, Bt) do { __builtin_amdgcn_s_setprio(1); _Pragma("unroll") for (int m = 0; m < 4; ++m) _Pragma("unroll") for (int n = 0; n < 2; ++n) _Pragma("unroll") for (int k = 0; k < 2; ++k) \
        acc[ai][bj][m][n] = __builtin_amdgcn_mfma_f32_16x16x32_bf16(Bt[n][k], At[m][k], acc[ai][bj][m][n], 0, 0, 0); __builtin_amdgcn_s_setprio(0); } while (0)
#define PG8_WAIT_V(n) asm volatile("s_waitcnt vmcnt(" #n ")" ::: "memory")
#define PG8_WAIT_L(n) asm volatile("s_waitcnt lgkmcnt(" #n ")" ::: "memory")
#define PG8_BAR __builtin_amdgcn_s_barrier()
#define PG8_SCHED __builtin_amdgcn_sched_barrier(0)
    Unit cur, nxt; int ui = 0;
    if (!S.next(0, cur)) return;
    Acc acc;
    S.begin(acc, cur, 0, wr, fr);
    bf16x8 At[4][2], B0[2][2], B1[2][2];
    {
        const char* cA = S.ka(cur, 0); const char* cB = S.kb(cur, 0); const char* cA1 = S.ka(cur, 1); const char* cB1 = S.kb(cur, 1);
        PG8_STAGE(PG8_SB(0, 0), cB, voffB); PG8_STAGE(PG8_SB(0, 1), cB + hstepB, voffB); PG8_STAGE(PG8_SA(0, 0), cA, voffA); PG8_STAGE(PG8_SA(0, 1), cA + hstepA, voffA);
        if (wr == 1) PG8_BAR;
        PG8_WAIT_V(2); PG8_BAR;
        PG8_STAGE(PG8_SB(1, 0), cB1, voffB); PG8_STAGE(PG8_SA(1, 0), cA1, voffA); PG8_STAGE(PG8_SB(1, 1), cB1 + hstepB, voffB);
        PG8_WAIT_V(6); PG8_BAR;
    }
    for (;;) {
        const bool has_next = S.next(ui + 1, nxt);
        const Unit nx = has_next ? nxt : cur;
#pragma unroll 1
        for (int t = 0; t < nt; t += 2) {
            const bool last = (t == nt - 2);
            const char* a1 = S.ka(cur, t + 1);
            const char* a2 = last ? S.ka(nx, 0) : S.ka(cur, t + 2); const char* b2 = last ? S.kb(nx, 0) : S.kb(cur, t + 2);
            const char* a3 = last ? S.ka(nx, 1) : S.ka(cur, t + 3); const char* b3 = last ? S.kb(nx, 1) : S.kb(cur, t + 3);
            PG8_LDB(B0, 0, 0); PG8_LDB(B1, 0, 1); PG8_SCHED; PG8_LDA(At, 0, 0); PG8_STAGE(PG8_SA(1, 1), a1 + hstepA, voffA);
            PG8_WAIT_V(8); PG8_WAIT_L(0); PG8_BAR; PG8_MMA(0, 0, At, B0); PG8_MMA(0, 1, At, B1); PG8_BAR; PG8_SCHED;
            PG8_LDA(At, 0, 1); PG8_STAGE(PG8_SB(0, 0), b2, voffB); PG8_STAGE(PG8_SB(0, 1), b2 + hstepB, voffB); PG8_STAGE(PG8_SA(0, 0), a2, voffA);
            PG8_WAIT_V(8); PG8_WAIT_L(0); PG8_BAR; PG8_MMA(1, 0, At, B0); PG8_MMA(1, 1, At, B1); PG8_BAR; PG8_SCHED;
            PG8_LDB(B0, 1, 0); PG8_LDB(B1, 1, 1); PG8_SCHED; PG8_LDA(At, 1, 0); PG8_STAGE(PG8_SA(0, 1), a2 + hstepA, voffA);
            PG8_WAIT_V(8); PG8_WAIT_L(0); PG8_BAR; PG8_MMA(0, 0, At, B0); PG8_MMA(0, 1, At, B1); PG8_BAR; PG8_SCHED;
            PG8_LDA(At, 1, 1); PG8_STAGE(PG8_SB(1, 0), b3, voffB); PG8_STAGE(PG8_SB(1, 1), b3 + hstepB, voffB); PG8_STAGE(PG8_SA(1, 0), a3, voffA);
            PG8_WAIT_V(8); PG8_WAIT_L(0); PG8_BAR; PG8_MMA(1, 0, At, B0); PG8_MMA(1, 1, At, B1); PG8_BAR; PG8_SCHED;
            if constexpr (Sched::HAS_MID) S.mid(acc, cur, t + 2, wr, fr);
        }
        if (wr == 0) PG8_BAR;
        E(acc, cur, wr, wc, fr, fq);
        if (!has_next) break;
        ++ui; S.begin(acc, nxt, ui, wr, fr);
        cur = nxt;
        if (wr == 1) PG8_BAR;
    }
    PG8_WAIT_V(0);
    PG8_BAR;
#undef PG8_SA
#undef PG8_SB
#undef PG8_STAGE
#undef PG8_LDA
#undef PG8_LDB
#undef PG8_MMA
#undef PG8_WAIT_V
#undef PG8_WAIT_L
#undef PG8_BAR
#undef PG8_SCHED
}

__device__ __forceinline__ void acc_zero(Acc& acc) {
#pragma unroll
    for (int a = 0; a < 2; ++a)
#pragma unroll
        for (int b = 0; b < 2; ++b)
#pragma unroll
            for (int m = 0; m < 4; ++m)
#pragma unroll
                for (int n = 0; n < 2; ++n) acc[a][b][m][n] = (f32x4){0.f, 0.f, 0.f, 0.f};
}
}
constexpr size_t MiB = 1u << 20;
constexpr size_t WS_CTL = 0;
constexpr size_t WS_WRI = 1 * MiB, WS_WRO = 13 * MiB, WS_W1A = 17 * MiB, WS_W2A = 25 * MiB, WS_WAI = 33 * MiB, WS_WAO = 36 * MiB, WS_W1B = 38 * MiB, WS_W2B = 46 * MiB;
constexpr size_t WS_COSR = 54 * MiB, WS_SINR = 55 * MiB, WS_COSRT = 56 * MiB, WS_SINRT = 57 * MiB;
constexpr size_t WS_COSA = 58 * MiB, WS_SINA = 58 * MiB + 512 * 1024;
constexpr size_t WS_RF0 = 59 * MiB;
constexpr size_t WS_SS = 448 * MiB + 8 * MiB;
constexpr size_t WS_YTMP = 464 * MiB;
constexpr size_t WS_XB = 64 * MiB;
constexpr size_t WS_YZ = 128 * MiB;
constexpr size_t WS_QH = 256 * MiB, WS_KH = 288 * MiB, WS_KTF = 320 * MiB, WS_KTB = 352 * MiB, WS_VT = 384 * MiB;
constexpr size_t WS_FF = 128 * MiB;
constexpr size_t WS_AQ = 384 * MiB, WS_AK = 464 * MiB + 0, WS_AV = 480 * MiB, WS_AO = 128 * MiB;
constexpr size_t WS_END = 512 * MiB;
static_assert(WS_SS + 4ull * MTOK * 16 * 4 <= WS_AK, "SS fits below AK");

struct P {
    const float *x, *norm_mix, *norm_mlp, *w1, *w2, *rwin, *rwout, *dfw, *dbw, *awin, *awout, *aqn, *akn, *fnorm;
    float* out; unsigned char* ws;
};
#define WSP(T, off) ((T*)(p.ws + (off)))

namespace pg8 {
template <int LDA_, int LDB_, int NT_> struct SchedBase {
    static constexpr int LDA = LDA_, LDB = LDB_, NT = NT_; static constexpr bool HAS_MID = false;
    __device__ __forceinline__ const char* ka(const Unit& u, int t) const { return u.a + (size_t)t * 128; }
    __device__ __forceinline__ const char* kb(const Unit& u, int t) const { return u.b + (size_t)t * 128; }
    __device__ __forceinline__ void begin(Acc& acc, const Unit&, int, int, int) const { acc_zero(acc); }
    __device__ __forceinline__ void mid(Acc&, const Unit&, int, int, int) const {}
};
template <int LDA_, int LDB_, int NT_> struct SchedDense : SchedBase<LDA_, LDB_, NT_> {
    const char* A; const char* B; int nM, nN, G, c;
    __device__ __forceinline__ bool next(int i, Unit& u) const {
        const int L = i * G + c; if (L >= nM * nN) return false;
        int pm, pn; tile_of(L, nM, nN, pm, pn); u.pm = pm; u.pn = pn; u.aux = 0;
        u.a = A + (size_t)pm * 256 * LDA_ * 2; u.b = B + (size_t)pn * 256 * LDB_ * 2; return true; }
};
struct SchedS : SchedBase<1024, 1024, 4> {
    const char* QH; const char* KH; int c;
    __device__ __forceinline__ bool next(int i, Unit& u) const {
        if (i >= 2) return false; const int L = c * 2 + i, bh = L >> 3, ch = L & 7, bl = bh >> 2, head = bh & 3;
        const size_t off = ((size_t)(bl * 2048 + ch * 256) * 1024 + head * 256) * 2; u.a = QH + off; u.b = KH + off; u.pm = bh; u.pn = ch; u.aux = 0; return true; }
};
struct SchedState : SchedBase<2048, 2048, 4> {
    const char* VT; const char* KTF; const char* KTB; int c; float gC;
    __device__ __forceinline__ bool next(int i, Unit& u) const {
        if (i >= 7) return false; const int bh = c >> 2, dir = (c >> 1) & 1, dvh = c & 1, bl = bh >> 2, head = bh & 3;
        const int src = dir ? 7 - i : i, dest = dir ? 6 - i : i + 1;
        u.a = VT + ((size_t)(bl * 2048 + head * 512 + dvh * 256) * 2048 + src * 256) * 2;
        u.b = (dir ? KTB : KTF) + ((size_t)(bl * 1024 + head * 256) * 2048 + src * 256) * 2; u.pm = c; u.pn = dest; u.aux = 0; return true; }
    __device__ __forceinline__ void begin(Acc& acc, const Unit&, int i, int, int) const {
        if (i == 0) acc_zero(acc);
        else {
#pragma unroll
            for (int a = 0; a < 2; ++a)
#pragma unroll
                for (int b = 0; b < 2; ++b)
#pragma unroll
                    for (int m = 0; m < 4; ++m)
#pragma unroll
                        for (int n = 0; n < 2; ++n) acc[a][b][m][n] *= gC; } }
};
struct SchedR3 : SchedBase<1024, 2048, 12> {
    static constexpr bool HAS_MID = true;
    const char* QH; const char* KH; const char* ST; const char* VT; const float* dfw; const float* dbw; int c;
    __device__ __forceinline__ bool next(int i, Unit& u) const {
        if (i >= 2) return false; const int L = c * 2 + i, bh = L >> 4, ch = (L >> 1) & 7, dvh = L & 1, bl = bh >> 2, head = bh & 3;
        u.a = QH + ((size_t)(bl * 2048 + ch * 256) * 1024 + head * 256) * 2; u.b = nullptr; u.pm = bh; u.pn = ch; u.aux = dvh; return true; }
    __device__ __forceinline__ const char* ka(const Unit& u, int t) const { return u.a + (t >= 8 ? (KH - QH) : 0) + (size_t)(t & 3) * 128; }
    __device__ __forceinline__ const char* kb(const Unit& u, int t) const {
        const int bh = u.pm, ch = u.pn, dvh = u.aux, bl = bh >> 2, head = bh & 3;
        const char* base = (t >= 8) ? VT + ((size_t)(bl * 2048 + head * 512 + dvh * 256) * 2048 + ch * 256) * 2
                                    : ST + ((size_t)((bh * 2 + (t < 4 ? 1 : 0)) * 512 + dvh * 256) * 2048 + ch * 256) * 2;
        return base + (size_t)(t & 3) * 128; }
    __device__ __forceinline__ void mid(Acc& acc, const Unit& u, int tdone, int wr, int fr) const {
        if (tdone != 4 && tdone != 8) return;
        asm volatile("" : "+v"(fr));
        const int head = u.pm & 3; const float l2f = -__expf(dfw[head]) * LOG2E, l2b = -__expf(dbw[head]) * LOG2E;
#pragma unroll
        for (int a = 0; a < 2; ++a)
#pragma unroll
            for (int m = 0; m < 4; ++m) { const float i = (float)(a * 128 + wr * 64 + m * 16 + fr);
                const float f = (tdone == 4) ? __builtin_amdgcn_exp2f(l2b * (256.f - i) - l2f * (i + 1.f)) : __builtin_amdgcn_exp2f(l2f * (i + 1.f));
#pragma unroll
                for (int b = 0; b < 2; ++b)
#pragma unroll
                    for (int n = 0; n < 2; ++n) acc[a][b][m][n] *= f; } }
};

__device__ __forceinline__ u32x4 pack8(const f32x4& v0, const f32x4& v1) { u32x4 w; w.x = cvt_pk_bf16(v0[0], v0[1]); w.y = cvt_pk_bf16(v0[2], v0[3]); w.z = cvt_pk_bf16(v1[0], v1[1]); w.w = cvt_pk_bf16(v1[2], v1[3]); return w; }
__device__ __forceinline__ float rf_of(const float* ss16) {
    const f32x4 a = *(const f32x4*)ss16, b = *(const f32x4*)(ss16 + 4), c = *(const f32x4*)(ss16 + 8), d = *(const f32x4*)(ss16 + 12);
    const float s = ((a[0] + a[1]) + (a[2] + a[3])) + ((b[0] + b[1]) + (b[2] + b[3])) + ((c[0] + c[1]) + (c[2] + c[3])) + ((d[0] + d[1]) + (d[2] + d[3]));
    return rsqrtf(s * (1.0f / 1024.0f) + RMS_EPS); }

struct EpiQK {
    bf16_t* QH; bf16_t* KH; const float* RF0; const float* COSR; const float* SINR; int hf;
    __device__ __forceinline__ void operator()(const Acc& acc, const Unit& u, int wr, int wc, int fr, int fq) const {
        asm volatile("" : "+v"(fr), "+v"(fq));
        const int head = u.pn & 3; const bool isK = u.pn >= 4; const float osc = isK ? 0.0625f : 1.0f; bf16_t* base = (isK ? KH : QH) + head * 256; const int i0 = wc * 32 + fq * 8;
#pragma unroll
        for (int ai = 0; ai < 2; ++ai)
#pragma unroll
            for (int m = 0; m < 4; ++m) { const int tl = u.pm * 256 + ai * 128 + wr * 64 + m * 16 + fr, tg = hf * HM + tl, s = tg & 2047; const float r = RF0[tg] * osc;
                const f32x4 c0 = *(const f32x4*)(COSR + s * 128 + i0), c1 = *(const f32x4*)(COSR + s * 128 + i0 + 4), s0 = *(const f32x4*)(SINR + s * 128 + i0), s1 = *(const f32x4*)(SINR + s * 128 + i0 + 4);
                const f32x4 x10 = acc[ai][0][m][0] * r, x11 = acc[ai][0][m][1] * r, x20 = acc[ai][1][m][0] * r, x21 = acc[ai][1][m][1] * r;
                const f32x4 o10 = x10 * c0 - x20 * s0, o11 = x11 * c1 - x21 * s1, o20 = x10 * s0 + x20 * c0, o21 = x11 * s1 + x21 * c1;
                bf16_t* rp = base + (size_t)tl * 1024 + i0; *(u32x4*)rp = pack8(o10, o11); *(u32x4*)(rp + 128) = pack8(o20, o21); }
    }
};
struct EpiKVT {
    bf16_t* KTF; bf16_t* KTB; bf16_t* VT; const float* RF0; const float* COSRT; const float* SINRT; const float* dfw; const float* dbw; int hf;
    __device__ __forceinline__ void operator()(const Acc& acc, const Unit& u, int wr, int wc, int fr, int fq) const {
        asm volatile("" : "+v"(fr), "+v"(fq));
        if (u.pm < 4) {
            const int head = u.pm; const float l2f = -__expf(dfw[head]) * LOG2E, l2b = -__expf(dbw[head]) * LOG2E;
#pragma unroll
            for (int bj = 0; bj < 2; ++bj) { const int tl0 = u.pn * 256 + bj * 128 + wc * 32 + fq * 8, tg0 = hf * HM + tl0, s0 = tg0 & 2047, bl = tl0 >> 11, j0 = tl0 & 255;
                f32x4 r0 = *(const f32x4*)(RF0 + tg0) * 0.0625f, r1 = *(const f32x4*)(RF0 + tg0 + 4) * 0.0625f, zf0, zf1, zb0, zb1;
#pragma unroll
                for (int e = 0; e < 4; ++e) { zf0[e] = __builtin_amdgcn_exp2f(l2f * (float)(255 - j0 - e)); zf1[e] = __builtin_amdgcn_exp2f(l2f * (float)(251 - j0 - e));
                    zb0[e] = __builtin_amdgcn_exp2f(l2b * (float)(j0 + e)); zb1[e] = __builtin_amdgcn_exp2f(l2b * (float)(j0 + 4 + e)); }
#pragma unroll
                for (int m = 0; m < 4; ++m) { const int i = wr * 64 + m * 16 + fr;
                    const f32x4 c0 = *(const f32x4*)(COSRT + i * 2048 + s0), c1 = *(const f32x4*)(COSRT + i * 2048 + s0 + 4), sn0 = *(const f32x4*)(SINRT + i * 2048 + s0), sn1 = *(const f32x4*)(SINRT + i * 2048 + s0 + 4);
                    const f32x4 x10 = acc[0][bj][m][0] * r0, x11 = acc[0][bj][m][1] * r1, x20 = acc[1][bj][m][0] * r0, x21 = acc[1][bj][m][1] * r1;
                    const f32x4 o10 = x10 * c0 - x20 * sn0, o11 = x11 * c1 - x21 * sn1, o20 = x10 * sn0 + x20 * c0, o21 = x11 * sn1 + x21 * c1;
                    const size_t off = (size_t)(bl * 1024 + head * 256 + i) * 2048 + s0;
                    *(u32x4*)(KTF + off) = pack8(o10 * zf0, o11 * zf1); *(u32x4*)(KTF + off + 128 * 2048) = pack8(o20 * zf0, o21 * zf1);
                    *(u32x4*)(KTB + off) = pack8(o10 * zb0, o11 * zb1); *(u32x4*)(KTB + off + 128 * 2048) = pack8(o20 * zb0, o21 * zb1); } }
        } else {
            const int vrow0 = (u.pm - 4) * 256;
#pragma unroll
            for (int bj = 0; bj < 2; ++bj) { const int tl0 = u.pn * 256 + bj * 128 + wc * 32 + fq * 8, tg0 = hf * HM + tl0, s0 = tg0 & 2047, bl = tl0 >> 11;
                const f32x4 r0 = *(const f32x4*)(RF0 + tg0), r1 = *(const f32x4*)(RF0 + tg0 + 4);
#pragma unroll
                for (int ai = 0; ai < 2; ++ai)
#pragma unroll
                    for (int m = 0; m < 4; ++m) { const int f = vrow0 + ai * 128 + wr * 64 + m * 16 + fr;
                        *(u32x4*)(VT + (size_t)(bl * 2048 + f) * 2048 + s0) = pack8(acc[ai][bj][m][0] * r0, acc[ai][bj][m][1] * r1); } }
        }
    }
};
struct EpiS {
    bf16_t* KH; const float* dfw; const float* dbw;
    __device__ __forceinline__ void operator()(const Acc& acc, const Unit& u, int wr, int wc, int fr, int fq) const {
        asm volatile("" : "+v"(fr), "+v"(fq));
        const int bh = u.pm, ch = u.pn, bl = bh >> 2, head = bh & 3; const float l2f = -__expf(dfw[head]) * LOG2E, l2b = -__expf(dbw[head]) * LOG2E;
        bf16_t* base = KH + (size_t)(bl * 2048 + ch * 256) * 1024 + head * 256;
#pragma unroll
        for (int ai = 0; ai < 2; ++ai)
#pragma unroll
            for (int m = 0; m < 4; ++m) { const int i = ai * 128 + wr * 64 + m * 16 + fr;
#pragma unroll
                for (int bj = 0; bj < 2; ++bj) { const int j0 = bj * 128 + wc * 32 + fq * 8; f32x4 v0, v1; const float dd = (float)(i - j0);
#pragma unroll
                    for (int e = 0; e < 4; ++e) { const float d0 = dd - (float)e, d1 = dd - (float)(4 + e);
                        v0[e] = acc[ai][bj][m][0][e] * __builtin_amdgcn_exp2f(l2f * fmaxf(d0, 0.f) - l2b * fminf(d0, 0.f));
                        v1[e] = acc[ai][bj][m][1][e] * __builtin_amdgcn_exp2f(l2f * fmaxf(d1, 0.f) - l2b * fminf(d1, 0.f)); }
                    *(u32x4*)(base + (size_t)i * 1024 + j0) = pack8(v0, v1); } }
    }
};
struct EpiState {
    bf16_t* ST;
    __device__ __forceinline__ void operator()(const Acc& acc, const Unit& u, int wr, int wc, int fr, int fq) const {
        asm volatile("" : "+v"(fr), "+v"(fq));
        const int c = u.pm, bh = c >> 2, dir = (c >> 1) & 1, dvh = c & 1, dest = u.pn;
        bf16_t* base = ST + (size_t)((bh * 2 + dir) * 512 + dvh * 256) * 2048 + dest * 256;
#pragma unroll
        for (int ai = 0; ai < 2; ++ai)
#pragma unroll
            for (int m = 0; m < 4; ++m) { const int r = ai * 128 + wr * 64 + m * 16 + fr;
#pragma unroll
                for (int bj = 0; bj < 2; ++bj) *(u32x4*)(base + (size_t)r * 2048 + bj * 128 + wc * 32 + fq * 8) = pack8(acc[ai][bj][m][0], acc[ai][bj][m][1]); }
    }
};
struct SchedG : SchedBase<1024, 1024, 16> {
    const char* XBh; const char* WG; int c;
    __device__ __forceinline__ bool next(int i, Unit& u) const {
        if (i >= 2) return false; const int bh = c >> 3, ch = c & 7, bl = bh >> 2, head = bh & 3;
        u.a = XBh + (size_t)(bl * 2048 + ch * 256) * 1024 * 2; u.b = WG + (size_t)(head * 512 + i * 256) * 1024 * 2; u.pm = bh; u.pn = ch; u.aux = i; return true; }
};
struct EpiG {
    bf16_t* YZ; const float* RF0; int hf;
    __device__ __forceinline__ void operator()(const Acc& acc, const Unit& u, int wr, int wc, int fr, int fq) const {
        asm volatile("" : "+v"(fr), "+v"(fq));
        const int bh = u.pm, ch = u.pn, dvh = u.aux, bl = bh >> 2, head = bh & 3; const int tg0 = hf * HM + bl * 2048 + ch * 256;
#pragma unroll
        for (int ai = 0; ai < 2; ++ai)
#pragma unroll
            for (int m = 0; m < 4; ++m) { const int tg = tg0 + ai * 128 + wr * 64 + m * 16 + fr; const float r = RF0[tg];
#pragma unroll
                for (int bj = 0; bj < 2; ++bj) { f32x4 z0, z1;
#pragma unroll
                    for (int e = 0; e < 4; ++e) { const float g0 = acc[ai][bj][m][0][e] * r, g1 = acc[ai][bj][m][1][e] * r;
                        z0[e] = g0 * __builtin_amdgcn_rcpf(1.f + __expf(-g0)); z1[e] = g1 * __builtin_amdgcn_rcpf(1.f + __expf(-g1)); }
                    *(u32x4*)(YZ + (size_t)tg * 2048 + head * 512 + dvh * 256 + bj * 128 + wc * 32 + fq * 8) = pack8(z0, z1); } }
    }
};
__device__ __forceinline__ u32x4 ld_nt16(const bf16_t* p) { return __builtin_nontemporal_load((const u32x4*)p); }
struct EpiYZ {
    bf16_t* YZ; bf16_t* Ytmp; LAS f32x2* tab; int hf;
    __device__ __forceinline__ void operator()(const Acc& acc, const Unit& u, int wr, int wc, int fr, int fq) const {
        asm volatile("" : "+v"(fr), "+v"(fq));
        const int bh = u.pm, ch = u.pn, dvh = u.aux, bl = bh >> 2, head = bh & 3; const int tg0 = hf * HM + bl * 2048 + ch * 256;
#pragma unroll
        for (int ai = 0; ai < 2; ++ai)
#pragma unroll
            for (int m = 0; m < 4; ++m) { const int rl = ai * 128 + wr * 64 + m * 16 + fr; float s = 0.f, q = 0.f;
#pragma unroll
                for (int bj = 0; bj < 2; ++bj) { const f32x4 v0 = acc[ai][bj][m][0], v1 = acc[ai][bj][m][1];
                    s += ((v0[0] + v0[1]) + (v0[2] + v0[3])) + ((v1[0] + v1[1]) + (v1[2] + v1[3]));
                    q += ((v0[0] * v0[0] + v0[1] * v0[1]) + (v0[2] * v0[2] + v0[3] * v0[3])) + ((v1[0] * v1[0] + v1[1] * v1[1]) + (v1[2] * v1[2] + v1[3] * v1[3]));
                    if (dvh == 0) *(u32x4*)(Ytmp + (size_t)rl * 256 + bj * 128 + wc * 32 + fq * 8) = pack8(v0, v1); }
                s += __shfl_xor(s, 16); s += __shfl_xor(s, 32); q += __shfl_xor(q, 16); q += __shfl_xor(q, 32);
                if (fq == 0) tab[(dvh * 256 + rl) * 4 + wc] = (f32x2){s, q}; }
        if (dvh == 0) return;
        asm volatile("s_waitcnt lgkmcnt(0)" ::: "memory"); __builtin_amdgcn_s_barrier(); asm volatile("" ::: "memory");
#pragma unroll
        for (int ai = 0; ai < 2; ++ai)
#pragma unroll
            for (int m = 0; m < 4; ++m) { const int rl = ai * 128 + wr * 64 + m * 16 + fr, tg = tg0 + rl;
                const LAS f32x4* t0 = (const LAS f32x4*)(tab + rl * 4); const LAS f32x4* t1 = (const LAS f32x4*)(tab + (256 + rl) * 4);
                const f32x4 a = t0[0], b = t0[1], c = t1[0], d = t1[1];
                const float sm = (a[0] + a[2]) + (b[0] + b[2]) + (c[0] + c[2]) + (d[0] + d[2]), sq = (a[1] + a[3]) + (b[1] + b[3]) + (c[1] + c[3]) + (d[1] + d[3]);
                const float mu = sm * (1.f / 512.f), var = fmaxf(sq * (1.f / 512.f) - mu * mu, 0.f), rstd = rsqrtf(var + GN_EPS);
#pragma unroll
                for (int bj = 0; bj < 2; ++bj) { const int co = bj * 128 + wc * 32 + fq * 8; bf16_t* z1p = YZ + (size_t)tg * 2048 + head * 512 + 256 + co; bf16_t* z0p = z1p - 256;
                    const u32x4 g1 = ld_nt16(z1p), g0 = ld_nt16(z0p), y0 = ld_nt16(Ytmp + (size_t)rl * 256 + co); const f32x4 v0 = acc[ai][bj][m][0], v1 = acc[ai][bj][m][1];
                    const f32x4 ga = {bf_lo(g1.x), bf_hi(g1.x), bf_lo(g1.y), bf_hi(g1.y)}, gb = {bf_lo(g1.z), bf_hi(g1.z), bf_lo(g1.w), bf_hi(g1.w)};
                    *(u32x4*)z1p = pack8(ga * ((v0 - mu) * rstd), gb * ((v1 - mu) * rstd));
                    const f32x4 ha = {bf_lo(g0.x), bf_hi(g0.x), bf_lo(g0.y), bf_hi(g0.y)}, hb = {bf_lo(g0.z), bf_hi(g0.z), bf_lo(g0.w), bf_hi(g0.w)};
                    const f32x4 ya = {bf_lo(y0.x), bf_hi(y0.x), bf_lo(y0.y), bf_hi(y0.y)}, yb = {bf_lo(y0.z), bf_hi(y0.z), bf_lo(y0.w), bf_hi(y0.w)};
                    *(u32x4*)z0p = pack8(ha * ((ya - mu) * rstd), hb * ((yb - mu) * rstd)); } }
    }
};
template <bool FIRST> struct EpiRes {
    const float* xin; bf16_t* HB; float* SS;
    __device__ __forceinline__ void operator()(const Acc& acc, const Unit& u, int wr, int wc, int fr, int fq) const {
        asm volatile("" : "+v"(fr), "+v"(fq));
#pragma unroll
        for (int ai = 0; ai < 2; ++ai)
#pragma unroll
            for (int m = 0; m < 4; ++m) { const int tg = u.pm * 256 + ai * 128 + wr * 64 + m * 16 + fr; float q = 0.f;
#pragma unroll
                for (int bj = 0; bj < 2; ++bj) { const size_t off = (size_t)tg * 1024 + u.pn * 256 + bj * 128 + wc * 32 + fq * 8; f32x4 h0, h1;
                    if (FIRST) { h0 = *(const f32x4*)(xin + off) + acc[ai][bj][m][0]; h1 = *(const f32x4*)(xin + off + 4) + acc[ai][bj][m][1]; }
                    else { const u32x4 w = *(const u32x4*)(HB + off);
                        h0 = (f32x4){bf_lo(w.x), bf_hi(w.x), bf_lo(w.y), bf_hi(w.y)} + acc[ai][bj][m][0]; h1 = (f32x4){bf_lo(w.z), bf_hi(w.z), bf_lo(w.w), bf_hi(w.w)} + acc[ai][bj][m][1]; }
                    *(u32x4*)(HB + off) = pack8(h0, h1);
                    q += ((h0[0] * h0[0] + h0[1] * h0[1]) + (h0[2] * h0[2] + h0[3] * h0[3])) + ((h1[0] * h1[0] + h1[1] * h1[1]) + (h1[2] * h1[2] + h1[3] * h1[3])); }
                q += __shfl_xor(q, 16); q += __shfl_xor(q, 32);
                if (fq == 0) SS[(size_t)tg * 16 + u.pn * 4 + wc] = q; }
    }
};
struct EpiFF {
    bf16_t* FF; const float* SS; int flags;
    __device__ __forceinline__ void operator()(const Acc& acc, const Unit& u, int wr, int wc, int fr, int fq) const {
        if (flags & 4) { if (acc[0][0][0][0][0] == 1.2345e30f) FF[0] = 1; return; }
        asm volatile("" : "+v"(fr), "+v"(fq));
#pragma unroll
        for (int ai = 0; ai < 2; ++ai)
#pragma unroll
            for (int m = 0; m < 4; ++m) { const int tg = u.pm * 256 + ai * 128 + wr * 64 + m * 16 + fr; const float r = (flags & 2) ? 1.f : rf_of(SS + (size_t)tg * 16);
#pragma unroll
                for (int bj = 0; bj < 2; ++bj) { f32x4 v0 = acc[ai][bj][m][0] * r, v1 = acc[ai][bj][m][1] * r;
#pragma unroll
                    for (int e = 0; e < 4; ++e) { v0[e] = fmaxf(v0[e], 0.f); v1[e] = fmaxf(v1[e], 0.f); }
                    const u32x4 w = pack8(v0 * v0, v1 * v1);
                    if (!(flags & 1) || w.x == 0x12345678u) *(u32x4*)(FF + (size_t)tg * 4096 + u.pn * 256 + bj * 128 + wc * 32 + fq * 8) = w; } }
    }
};
struct EpiQKVfused {
    bf16_t* AQ; bf16_t* AK; bf16_t* AV; const float* SS; const float* COSA; const float* SINA; const float* qg; const float* kg; LAS float* xch;
    __device__ __forceinline__ void operator()(const Acc& acc, const Unit& u, int wr, int wc, int fr, int fq) const {
        asm volatile("" : "+v"(fr), "+v"(fq));
        if (u.pn == 5) {
#pragma unroll
            for (int ai = 0; ai < 2; ++ai)
#pragma unroll
                for (int m = 0; m < 4; ++m) { const int tg = u.pm * 256 + ai * 128 + wr * 64 + m * 16 + fr; const float r = rf_of(SS + (size_t)tg * 16);
#pragma unroll
                    for (int bj = 0; bj < 2; ++bj) *(u32x4*)(AV + (size_t)tg * 256 + bj * 128 + wc * 32 + fq * 8) = pack8(acc[ai][bj][m][0] * r, acc[ai][bj][m][1] * r); }
            asm volatile("s_waitcnt lgkmcnt(0)" ::: "memory"); __builtin_amdgcn_s_barrier(); asm volatile("" ::: "memory");
            return; }
        float rrow[2][4];
#pragma unroll
        for (int ai = 0; ai < 2; ++ai)
#pragma unroll
            for (int m = 0; m < 4; ++m) { const int rl = ai * 128 + wr * 64 + m * 16 + fr, tg = u.pm * 256 + rl; const float r = rf_of(SS + (size_t)tg * 16); rrow[ai][m] = r;
#pragma unroll
                for (int bj = 0; bj < 2; ++bj) { const f32x4 v0 = acc[ai][bj][m][0] * r, v1 = acc[ai][bj][m][1] * r;
                    float q = ((v0[0] * v0[0] + v0[1] * v0[1]) + (v0[2] * v0[2] + v0[3] * v0[3])) + ((v1[0] * v1[0] + v1[1] * v1[1]) + (v1[2] * v1[2] + v1[3] * v1[3]));
                    q += __shfl_xor(q, 16); q += __shfl_xor(q, 32);
                    if (fq == 0) xch[(rl * 2 + bj) * 4 + wc] = q; } }
        asm volatile("s_waitcnt lgkmcnt(0)" ::: "memory"); __builtin_amdgcn_s_barrier(); asm volatile("" ::: "memory");
        const bool isK = (u.pn == 4); const float* g = isK ? kg : qg; const int j0 = wc * 16 + fq * 4;
        const f32x4 g0 = *(const f32x4*)(g + j0), g1 = *(const f32x4*)(g + 64 + j0);
        bf16_t* dst = isK ? AK : AQ + u.pn * 256; const int ld = isK ? 256 : 1024;
#pragma unroll
        for (int ai = 0; ai < 2; ++ai)
#pragma unroll
            for (int m = 0; m < 4; ++m) { const int rl = ai * 128 + wr * 64 + m * 16 + fr, tg = u.pm * 256 + rl, sp = tg & 2047;
                const f32x4 c = *(const f32x4*)(COSA + sp * 64 + j0), sn = *(const f32x4*)(SINA + sp * 64 + j0);
#pragma unroll
                for (int bj = 0; bj < 2; ++bj) { const f32x4 pq = *(const LAS f32x4*)(xch + (rl * 2 + bj) * 4);
                    const float rn = rsqrtf(((pq[0] + pq[1]) + (pq[2] + pq[3])) * (1.f / 128.f) + RMS_EPS) * rrow[ai][m];
                    const f32x4 x1 = acc[ai][bj][m][0] * rn * g0, x2 = acc[ai][bj][m][1] * rn * g1;
                    *(u32x4*)(dst + (size_t)tg * ld + bj * 128 + wc * 32 + fq * 8) = pack8(x1 * c - x2 * sn, x1 * sn + x2 * c); } }
    }
};
}
namespace att {
constexpr int D = 128, NW = 8, QBLK = 32, KVBLK = 64;
constexpr float SCALE = 0.088388347648318440f;
constexpr float THR = 8.f;
constexpr int LDQ = 1024, LDK = 256, LDO = 1024;
constexpr size_t SHM_V = KVBLK * D * 2, SHM_K = KVBLK * D * 2, SHM_ATTN = 2 * SHM_V + 2 * SHM_K + NW * 64 * 4;
using s16x4 = __attribute__((ext_vector_type(4))) short;
using f32x16 = __attribute__((ext_vector_type(16))) float;
#define KSWZ(row, colB) ((row) * 256 + ((colB) ^ (((row) & 7) << 4)))
#define SBAR() __builtin_amdgcn_sched_barrier(0)
__device__ __forceinline__ int crow(int r, int hi) { return (r & 3) + 8 * (r >> 2) + 4 * hi; }
__device__ __forceinline__ unsigned cvtpk(float lo, float hi) { unsigned r; asm volatile("v_cvt_pk_bf16_f32 %0, %1, %2" : "=v"(r) : "v"(lo), "v"(hi)); return r; }
__device__ __forceinline__ void partialSM(f32x16& p0, f32x16& p1, float& m_reg, float& mn, float& alpha) {
  constexpr float C = SCALE * 1.4426950408889634f;
  float pmax = p0[0]; for (int r = 1; r < 16; ++r) pmax = fmaxf(pmax, p0[r]); for (int r = 0; r < 16; ++r) pmax = fmaxf(pmax, p1[r]);
  { auto rr = __builtin_amdgcn_permlane32_swap(__float_as_uint(pmax), __float_as_uint(pmax), false, false);
    pmax = fmaxf(__uint_as_float(rr[0]), __uint_as_float(rr[1])); }
  if (__builtin_expect(__all(pmax - m_reg <= THR / SCALE), 1)) { mn = m_reg; alpha = 1.f; }
  else { mn = fmaxf(m_reg, pmax); alpha = __builtin_amdgcn_exp2f((m_reg - mn) * C); m_reg = mn; }
  float mnC = -mn * C;
  for (int r = 0; r < 16; ++r) p0[r] = fmaf(p0[r], C, mnC); for (int r = 0; r < 16; ++r) p1[r] = fmaf(p1[r], C, mnC);
  for (int r = 0; r < 16; ++r) p0[r] = __builtin_amdgcn_exp2f(p0[r]);
}
__device__ __forceinline__ void finishSM(f32x16& p0, f32x16& p1, float alpha, float& l_reg, bf16x8& pa0, bf16x8& pa1, bf16x8& pa2, bf16x8& pa3) {
  for (int r = 0; r < 16; ++r) p1[r] = __builtin_amdgcn_exp2f(p1[r]);
  float ps = 0; for (int r = 0; r < 16; ++r) ps += p0[r]; for (int r = 0; r < 16; ++r) ps += p1[r];
  { auto rr = __builtin_amdgcn_permlane32_swap(__float_as_uint(ps), __float_as_uint(ps), false, false);
    ps = __uint_as_float(rr[0]) + __uint_as_float(rr[1]); }
  l_reg = l_reg * alpha + ps;
#define PK4(P, BASE, OUT) do { unsigned a0 = cvtpk(P[BASE + 0], P[BASE + 1]), a1 = cvtpk(P[BASE + 2], P[BASE + 3]);   \
    unsigned b0 = cvtpk(P[BASE + 4], P[BASE + 5]), b1 = cvtpk(P[BASE + 6], P[BASE + 7]);                              \
    auto r0 = __builtin_amdgcn_permlane32_swap(a0, b0, false, false); auto r1 = __builtin_amdgcn_permlane32_swap(a1, b1, false, false); \
    u32x4 w = {r0[0], r1[0], r0[1], r1[1]}; OUT = *reinterpret_cast<bf16x8*>(&w); } while (0)
  PK4(p0, 0, pa0); PK4(p0, 8, pa1); PK4(p1, 0, pa2); PK4(p1, 8, pa3);
#undef PK4
}
__device__ __forceinline__ void qkt(f32x16& p0, f32x16& p1, const bf16_t* Ks, const bf16x8* qr, int r32, int hi) {
  p0 = f32x16{}; p1 = f32x16{};
  for (int d0 = 0; d0 < 8; ++d0) { int cb = (d0 * 16 + hi * 8) * 2;
    bf16x8 b0 = *reinterpret_cast<const bf16x8*>((const char*)Ks + KSWZ(r32, cb));
    bf16x8 b1 = *reinterpret_cast<const bf16x8*>((const char*)Ks + KSWZ(32 + r32, cb));
    p0 = __builtin_amdgcn_mfma_f32_32x32x16_bf16(b0, qr[d0], p0, 0, 0, 0);
    p1 = __builtin_amdgcn_mfma_f32_32x32x16_bf16(b1, qr[d0], p1, 0, 0, 0); }
}
__device__ __forceinline__ int v_st(int k, int c) { const int kk = (k & ~0xC) | ((k & 4) << 1) | ((k & 8) >> 1); return ((kk >> 3) * 4 + (c >> 5)) * 512 + ((kk & 7) * 32 + (c & 31)) * 2; }
__device__ __forceinline__ int v_rd_base(int lane) { return ((lane & 3) << 3) | (((lane >> 2) & 3) << 6) | (((lane >> 4) & 1) << 5) | (((lane >> 5) & 1) << 8); }
constexpr int v_rd_off(int d0, int ks, int half) { return d0 * 512 + ks * 4096 + half * 2048; }
template <int OFF> __device__ __forceinline__ s16x4 tr_read(int vb) {
  s16x4 r; asm volatile("ds_read_b64_tr_b16 %0, %1 offset:%2" : "=&v"(r) : "v"(vb), "i"(OFF) : "memory"); return r;
}
template <int D0> __device__ __forceinline__ void pv_one(f32x16& od, int vb, bf16x8 pa0, bf16x8 pa1, bf16x8 pa2, bf16x8 pa3) {
  const s16x4 l0 = tr_read<v_rd_off(D0, 0, 0)>(vb), h0 = tr_read<v_rd_off(D0, 0, 1)>(vb), l1 = tr_read<v_rd_off(D0, 1, 0)>(vb), h1 = tr_read<v_rd_off(D0, 1, 1)>(vb);
  const s16x4 l2 = tr_read<v_rd_off(D0, 2, 0)>(vb), h2 = tr_read<v_rd_off(D0, 2, 1)>(vb), l3 = tr_read<v_rd_off(D0, 3, 0)>(vb), h3 = tr_read<v_rd_off(D0, 3, 1)>(vb);
  asm volatile("s_waitcnt lgkmcnt(0)" ::: "memory"); SBAR();
#define PK(L, H) (bf16x8){L[0], L[1], L[2], L[3], H[0], H[1], H[2], H[3]}
  od = __builtin_amdgcn_mfma_f32_32x32x16_bf16(pa0, PK(l0, h0), od, 0, 0, 0);
  od = __builtin_amdgcn_mfma_f32_32x32x16_bf16(pa1, PK(l1, h1), od, 0, 0, 0);
  od = __builtin_amdgcn_mfma_f32_32x32x16_bf16(pa2, PK(l2, h2), od, 0, 0, 0);
  od = __builtin_amdgcn_mfma_f32_32x32x16_bf16(pa3, PK(l3, h3), od, 0, 0, 0);
#undef PK
}
__device__ __forceinline__ void pv_d0(f32x16* o, int vb, bf16x8 pa0, bf16x8 pa1, bf16x8 pa2, bf16x8 pa3) {
  pv_one<0>(o[0], vb, pa0, pa1, pa2, pa3); pv_one<1>(o[1], vb, pa0, pa1, pa2, pa3); pv_one<2>(o[2], vb, pa0, pa1, pa2, pa3); pv_one<3>(o[3], vb, pa0, pa1, pa2, pa3);
}
__device__ __forceinline__ void attn_dense_body(const bf16_t* __restrict__ Qb, const bf16_t* __restrict__ Kh, const bf16_t* __restrict__ Vh, bf16_t* __restrict__ Ob, int seq, char* lds, int wave_id) {
  int tid = wave_id * 64 + lane_id(); asm volatile("" : "+v"(tid));
  const int wid = wave_id, lane = tid & 63, r32 = lane & 31, hi = lane >> 5;
  bf16_t* V_lds = (bf16_t*)lds; bf16_t* K_lds = (bf16_t*)(lds + 2 * SHM_V);
  float* ws = (float*)(lds + 2 * SHM_V + 2 * SHM_K) + wid * 64; float* li_l = ws; float* al_l = ws + 32;
  float m_reg = -1e30f, l_reg = 0; f32x16 o[4] = {}; bf16x8 qr[8];
  const bf16_t* Qw = Qb + (long)(wid * QBLK + r32) * LDQ + hi * 8;
#pragma unroll
  for (int d0 = 0; d0 < 8; ++d0) qr[d0] = *reinterpret_cast<const bf16x8*>(Qw + d0 * 16);
  const int sr = tid >> 4, sc = (tid & 15) * 8, vst0 = v_st(sr, sc), vst1 = v_st(32 + sr, sc);
  const int vb0 = (int)(uintptr_t)V_lds + v_rd_base(lane);
  struct { bf16x8 vs0, vs1, ks0, ks1; } sr_[2];
#define SLOAD(i, k0) do { sr_[i].vs0 = *reinterpret_cast<const bf16x8*>(&Vh[(long)((k0) + sr) * LDK + sc]); sr_[i].vs1 = *reinterpret_cast<const bf16x8*>(&Vh[(long)((k0) + 32 + sr) * LDK + sc]); \
    sr_[i].ks0 = *reinterpret_cast<const bf16x8*>(&Kh[(long)((k0) + sr) * LDK + sc]); sr_[i].ks1 = *reinterpret_cast<const bf16x8*>(&Kh[(long)((k0) + 32 + sr) * LDK + sc]); } while (0)
#define SWRITE(b, i) do { *(bf16x8*)((char*)V_lds + (b) * SHM_V + vst0) = sr_[i].vs0;          \
    *(bf16x8*)((char*)V_lds + (b) * SHM_V + vst1) = sr_[i].vs1; int kc = sc * 2;               \
    *(bf16x8*)((char*)K_lds + (b) * SHM_K + KSWZ(sr, kc)) = sr_[i].ks0;                       \
    *(bf16x8*)((char*)K_lds + (b) * SHM_K + KSWZ(32 + sr, kc)) = sr_[i].ks1; } while (0)
#define SWAIT() asm volatile("s_waitcnt vmcnt(4)" ::: "memory")
#define RESC(a) do { if (__any((a) < 1.f)) { if (hi == 0) al_l[r32] = (a); asm volatile("s_waitcnt lgkmcnt(0)" ::: "memory"); \
    for (int d = 0; d < 4; ++d) for (int r = 0; r < 16; ++r) o[d][r] *= al_l[crow(r, hi)]; } } while (0)
  f32x16 pA0, pA1, pB0, pB1; float mnA, mnB, alA, alB; bf16x8 pa0, pa1, pa2, pa3; const int NT = seq / KVBLK;
  constexpr int SE = 0, SO = 1;
  SLOAD(SE, 0); asm volatile("s_waitcnt vmcnt(0)" ::: "memory"); SWRITE(0, SE); __syncthreads();
  qkt(pA0, pA1, K_lds, qr, r32, hi); partialSM(pA0, pA1, m_reg, mnA, alA);
  SLOAD(SO, KVBLK); if (2 < NT) SLOAD(SE, 2 * KVBLK);
  SWAIT(); SWRITE(1, SO); __syncthreads();
  for (int j = 1; j + 1 < NT; j += 2) {
    SBAR(); qkt(pB0, pB1, (bf16_t*)((char*)K_lds + SHM_K), qr, r32, hi);
    finishSM(pA0, pA1, alA, l_reg, pa0, pa1, pa2, pa3); SBAR();
    SLOAD(SO, (j + 2) * KVBLK); SBAR();
    pv_d0(o, vb0, pa0, pa1, pa2, pa3); partialSM(pB0, pB1, m_reg, mnB, alB);
    __syncthreads(); SWAIT(); SWRITE(0, SE);
    RESC(alB); __syncthreads();
    SBAR(); qkt(pA0, pA1, K_lds, qr, r32, hi);
    finishSM(pB0, pB1, alB, l_reg, pa0, pa1, pa2, pa3); SBAR();
    if (j + 3 < NT) SLOAD(SE, (j + 3) * KVBLK); SBAR();
    pv_d0(o, vb0 + (int)SHM_V, pa0, pa1, pa2, pa3); partialSM(pA0, pA1, m_reg, mnA, alA);
    __syncthreads(); SWAIT(); SWRITE(1, SO);
    RESC(alA); __syncthreads();
  }
  SBAR(); qkt(pB0, pB1, (bf16_t*)((char*)K_lds + SHM_K), qr, r32, hi);
  finishSM(pA0, pA1, alA, l_reg, pa0, pa1, pa2, pa3); SBAR();
  pv_d0(o, vb0, pa0, pa1, pa2, pa3); partialSM(pB0, pB1, m_reg, mnB, alB);
  __syncthreads(); RESC(alB);
  finishSM(pB0, pB1, alB, l_reg, pa0, pa1, pa2, pa3); SBAR();
  pv_d0(o, vb0 + (int)SHM_V, pa0, pa1, pa2, pa3);
  if (hi == 0) li_l[r32] = l_reg; asm volatile("s_waitcnt lgkmcnt(0)" ::: "memory");
  __syncthreads();
  { bf16_t* stg = (bf16_t*)lds + wid * 4096;
#pragma unroll
    for (int r = 0; r < 16; ++r) { const int orow = crow(r, hi); const float rl = __builtin_amdgcn_rcpf(li_l[orow]);
#pragma unroll
      for (int d0 = 0; d0 < 4; ++d0) { const float v = o[d0][r] * rl; stg[orow * 128 + d0 * 32 + r32] = (bf16_t)(cvtpk(v, v) & 0xffffu); } }
    asm volatile("s_waitcnt lgkmcnt(0)" ::: "memory");
    bf16_t* Ow = Ob + (long)(wid * QBLK) * LDO;
#pragma unroll
    for (int i = 0; i < 8; ++i) { const int row = i * 4 + (lane >> 4), ch = lane & 15; const u32x4 v = *(const u32x4*)(stg + row * 128 + ch * 8); *(u32x4*)(Ow + (long)row * LDO + ch * 8) = v; } }
  __syncthreads();
#undef SLOAD
#undef SWRITE
#undef SWAIT
#undef RESC
}
#undef KSWZ
#undef SBAR
}
constexpr int NWAVES = 8, NTHREADS = 512;
constexpr int RING_BYTES = 131072, LDS_BYTES = 163840;
#define LDS_WAIT() asm volatile("s_waitcnt lgkmcnt(0)" ::: "memory")
#define VM_WAIT() asm volatile("s_waitcnt vmcnt(0)" ::: "memory")
__device__ __forceinline__ unsigned f2bf(float f) { unsigned u = __builtin_bit_cast(unsigned, f); return (u + 0x7fffu + ((u >> 16) & 1u)) >> 16; }
__device__ __forceinline__ unsigned pk2(float lo, float hi) { return f2bf(lo) | (f2bf(hi) << 16); }
__device__ __forceinline__ float wave_sum(float v) {
#pragma unroll
    for (int o = 1; o < 64; o <<= 1) v += __shfl_xor(v, o);
    return v;
}

struct Frame { LAS unsigned char* lds; int wave, vcu, G; };

__device__ __forceinline__ int qk_perm_row(int n) { if (n >= 1280) return n; const int d = n & 127, j = d & 63; return (n & ~127) + 8 * (j >> 2) + 4 * (d >> 6) + (j & 3); }
__device__ __forceinline__ void p0_transpose_item(const float* W, int K, int N, bf16_t* WT, const float* gain, LAS float* scr, int item, int lane, bool perm = false) {
    const int nblk = N / 32, kb = item / nblk, nb = item % nblk, k0 = 64 * kb, n0 = 32 * nb;
#pragma unroll 8
    for (int i = 0; i < 32; ++i) { const int kk = 2 * i + (lane >> 5); float v = W[(size_t)(k0 + kk) * N + n0 + (lane & 31)]; if (gain) v *= gain[k0 + kk]; scr[kk * 33 + (lane & 31)] = v; }
    LDS_WAIT(); asm volatile("" ::: "memory");
    const int c = lane & 7;
#pragma unroll
    for (int j = 0; j < 4; ++j) { const int n = (lane >> 3) + 8 * j; const LAS float* s = scr + (8 * c) * 33 + n;
        u32x4 o; o.x = pk2(s[0 * 33], s[1 * 33]); o.y = pk2(s[2 * 33], s[3 * 33]); o.z = pk2(s[4 * 33], s[5 * 33]); o.w = pk2(s[6 * 33], s[7 * 33]);
        *(u32x4*)(WT + (size_t)(perm ? qk_perm_row(n0 + n) : n0 + n) * K + k0 + 8 * c) = o; }
    LDS_WAIT(); asm volatile("" ::: "memory");
}
__device__ __forceinline__ void convert_late_weights(const P& p, Frame& F, int set, int slot, int nslots) {
    int lane = lane_id(); asm volatile("" : "+v"(lane));
    LAS float* scr = (LAS float*)(F.lds + F.wave * 16384);
    constexpr int I_RO = (2048 / 64) * (1024 / 32), I_1 = (1024 / 64) * (4096 / 32), I_2 = (4096 / 64) * (1024 / 32), I_AI = (1024 / 64) * (1536 / 32), I_AO = (1024 / 64) * (1024 / 32);
    if (set == 0) {
        for (int it = slot; it < I_RO + I_1 + I_2; it += nslots) { int r = it;
            if (r < I_RO) { p0_transpose_item(p.rwout, 2048, 1024, WSP(bf16_t, WS_WRO), nullptr, scr, r, lane); continue; } r -= I_RO;
            if (r < I_1) { p0_transpose_item(p.w1, 1024, 4096, WSP(bf16_t, WS_W1A), p.norm_mlp, scr, r, lane); continue; } r -= I_1;
            p0_transpose_item(p.w2, 4096, 1024, WSP(bf16_t, WS_W2A), nullptr, scr, r, lane); }
    } else {
        for (int it = slot; it < I_AI + I_AO + I_1 + I_2; it += nslots) { int r = it;
            if (r < I_AI) { p0_transpose_item(p.awin, 1024, 1536, WSP(bf16_t, WS_WAI), p.norm_mix + 1024, scr, r, lane, true); continue; } r -= I_AI;
            if (r < I_AO) { p0_transpose_item(p.awout, 1024, 1024, WSP(bf16_t, WS_WAO), nullptr, scr, r, lane); continue; } r -= I_AO;
            if (r < I_1) { p0_transpose_item(p.w1 + (size_t)1024 * 4096, 1024, 4096, WSP(bf16_t, WS_W1B), p.norm_mlp + 1024, scr, r, lane); continue; } r -= I_1;
            p0_transpose_item(p.w2 + (size_t)4096 * 1024, 4096, 1024, WSP(bf16_t, WS_W2B), nullptr, scr, r, lane); }
    }
}
__device__ __forceinline__ void phase_prologue(const P& p, Frame& F) {
    int lane = lane_id(); asm volatile("" : "+v"(lane)); const int tid = F.wave * 64 + lane;
    LAS float* scr = (LAS float*)(F.lds + F.wave * 16384);
    const int gw = F.vcu * NWAVES + F.wave, NGW = F.G * NWAVES;
    constexpr int I_RI = (1024 / 64) * (6144 / 32);
    for (int it = gw; it < I_RI; it += NGW) p0_transpose_item(p.rwin, 1024, 6144, WSP(bf16_t, WS_WRI), p.norm_mix, scr, it, lane);
    const int gt = F.vcu * NTHREADS + tid, NGT = F.G * NTHREADS;
    for (int idx = gt; idx < 2048 * 128; idx += NGT) { const int t = idx >> 7, i = idx & 127, f = i & 63; const float pos = (i < 64) ? (float)(t >> 6) : (float)(t & 63);
        const float ang = pos * powf(10000.0f, -(float)f * 2.0f / 128.0f); const float c = cosf(ang), s = sinf(ang);
        WSP(float, WS_COSR)[idx] = c; WSP(float, WS_SINR)[idx] = s; WSP(float, WS_COSRT)[i * 2048 + t] = c; WSP(float, WS_SINRT)[i * 2048 + t] = s; }
    for (int idx = gt; idx < 2048 * 64; idx += NGT) { const int t = idx >> 6, i = idx & 63, f = i & 31; const float pos = (i < 32) ? (float)(t >> 6) : (float)(t & 63);
        const float ang = pos * powf(10000.0f, -(float)f * 2.0f / 64.0f); WSP(float, WS_COSA)[idx] = cosf(ang); WSP(float, WS_SINA)[idx] = sinf(ang); }
    for (int m = gw; m < MTOK; m += NGW) {
        const f32x4* xr = (const f32x4*)(p.x + (size_t)m * 1024) + lane; f32x4 v[4]; float s = 0.f;
#pragma unroll
        for (int j = 0; j < 4; ++j) { v[j] = xr[64 * j]; s += (v[j].x * v[j].x + v[j].y * v[j].y) + (v[j].z * v[j].z + v[j].w * v[j].w); }
        s = wave_sum(s); if (lane == 0) WSP(float, WS_RF0)[m] = rsqrtf(s * (1.f / 1024.f) + RMS_EPS);
        unsigned long long* o8 = (unsigned long long*)(WSP(bf16_t, WS_XB) + (size_t)m * 1024) + lane;
#pragma unroll
        for (int j = 0; j < 4; ++j) o8[64 * j] = (unsigned long long)pk2(v[j].x, v[j].y) | ((unsigned long long)pk2(v[j].z, v[j].w) << 32);
    }
}
__device__ __forceinline__ void phase_qknorm(const P& p, Frame& F) {
    int lane = lane_id(); asm volatile("" : "+v"(lane));
    const int gw = F.vcu * NWAVES + F.wave, NGW = F.G * NWAVES; const int hl = lane & 31, hs = lane >> 5;
    const float* COSA = WSP(float, WS_COSA); const float* SINA = WSP(float, WS_SINA);
    for (int it = gw; it < MTOK * 5; it += NGW) { const int pr = it * 2 + hs, tg = pr / 10, hh = pr % 10;
        bf16_t* row = hh < 8 ? WSP(bf16_t, WS_AQ) + (size_t)tg * 1024 + hh * 128 : WSP(bf16_t, WS_AK) + (size_t)tg * 256 + (hh - 8) * 128; const float* g = hh < 8 ? p.aqn : p.akn;
        const unsigned w1 = *(const unsigned*)(row + 2 * hl), w2 = *(const unsigned*)(row + 64 + 2 * hl);
        float a0 = pg8::bf_lo(w1), a1 = pg8::bf_hi(w1), b0 = pg8::bf_lo(w2), b1 = pg8::bf_hi(w2); float s = (a0 * a0 + a1 * a1) + (b0 * b0 + b1 * b1);
#pragma unroll
        for (int o = 1; o < 32; o <<= 1) s += __shfl_xor(s, o);
        const float r = rsqrtf(s * (1.f / 128.f) + RMS_EPS); const f32x2 ga = *(const f32x2*)(g + 2 * hl), gb = *(const f32x2*)(g + 64 + 2 * hl);
        a0 *= r * ga.x; a1 *= r * ga.y; b0 *= r * gb.x; b1 *= r * gb.y;
        const int sp = tg & 2047; const f32x2 c = *(const f32x2*)(COSA + sp * 64 + 2 * hl), sn = *(const f32x2*)(SINA + sp * 64 + 2 * hl);
        *(unsigned*)(row + 2 * hl) = pk2(a0 * c.x - b0 * sn.x, a1 * c.y - b1 * sn.y); *(unsigned*)(row + 64 + 2 * hl) = pk2(a0 * sn.x + b0 * c.x, a1 * sn.y + b1 * c.y); }
}
__device__ __forceinline__ void phase_final(const P& p, Frame& F, const float* SS) {
    int lane = lane_id(); asm volatile("" : "+v"(lane));
    const int gw = F.vcu * NWAVES + F.wave, NGW = F.G * NWAVES;
    for (int m = gw; m < MTOK; m += NGW) { const float r = pg8::rf_of(SS + (size_t)m * 16); const u32x4* hr = (const u32x4*)(WSP(bf16_t, WS_XB) + (size_t)m * 1024) + lane; f32x4* orow = (f32x4*)(p.out + (size_t)m * 1024) + 2 * lane; const f32x4* gr = (const f32x4*)p.fnorm + 2 * lane;
#pragma unroll
        for (int j = 0; j < 2; ++j) { const u32x4 w = hr[64 * j];
            orow[128 * j] = (f32x4){pg8::bf_lo(w.x), pg8::bf_hi(w.x), pg8::bf_lo(w.y), pg8::bf_hi(w.y)} * r * gr[128 * j];
            orow[128 * j + 1] = (f32x4){pg8::bf_lo(w.z), pg8::bf_hi(w.z), pg8::bf_lo(w.w), pg8::bf_hi(w.w)} * r * gr[128 * j + 1]; } }
}

#define XB_TMO      128
#define XB_XCNT(j)  (256  + 64 * (j))
#define XB_XSUB(j)  (1280 + 64 * (j))
#define XB_XGEN(j)  (2304 + 64 * (j))
#define XB_TOP      3328
#define XB_TOPGEN   3392
#define XCD_BAR_WORDS 3456
#define XB_SPIN_CAP (1u << 22)
__device__ __forceinline__ unsigned xb_ld(unsigned* p)              { return __hip_atomic_load(p, __ATOMIC_RELAXED, __HIP_MEMORY_SCOPE_AGENT); }
__device__ __forceinline__ unsigned xb_add(unsigned* p, unsigned v) { return __hip_atomic_fetch_add(p, v, __ATOMIC_RELAXED, __HIP_MEMORY_SCOPE_AGENT); }
__device__ __forceinline__ unsigned xb_xcc_id() { return (unsigned)__builtin_amdgcn_s_getreg((3 << 11) | 20) & 0xFu; }
#define XB_SPIN(cond, bar) do { unsigned _sp = 0; while (cond) { __builtin_amdgcn_s_sleep(1); \
    if ((++_sp & 255u) == 0u) { if (xb_ld(&(bar)[XB_TMO])) break; if (_sp > XB_SPIN_CAP) { atomicAdd(&(bar)[XB_TMO], 1u); break; } } } } while (0)
struct XcdBarrier { unsigned* bar; unsigned x; volatile LAS unsigned* st; };
__device__ __forceinline__ XcdBarrier xcd_barrier_post(unsigned* bar, volatile LAS unsigned* st, bool leader) {
    XcdBarrier b; b.bar = bar; b.x = xb_xcc_id(); b.st = st;
    if (leader) (void)xb_add(&bar[XB_XCNT(b.x)], 1u);
    return b;
}
__device__ __forceinline__ void xcd_barrier_complete(unsigned* bar, unsigned x, unsigned& nloc, unsigned& nx) {
    const unsigned G = gridDim.x * gridDim.y * gridDim.z;
    unsigned sum, cnt, mine, sp = 0u;
    for (;;) {
        sum = 0u; cnt = 0u; mine = 0u;
#pragma unroll
        for (unsigned j = 0; j < 16; ++j) { const unsigned c = xb_ld(&bar[XB_XCNT(j)]); sum += c; cnt += (c > 0u) ? 1u : 0u; mine = (j == x) ? c : mine; }
        if (sum == G) break;
        __builtin_amdgcn_s_sleep(1);
        if ((++sp & 255u) == 0u) { if (xb_ld(&bar[XB_TMO])) break; if (sp > XB_SPIN_CAP) { atomicAdd(&bar[XB_TMO], 1u); break; } }
    }
    nloc = mine > 0u ? mine : 1u; nx = cnt > 0u ? cnt : 1u;
}
__device__ __forceinline__ void xcd_barrier(const XcdBarrier& b, bool leader) {
    asm volatile("s_waitcnt vmcnt(0)" ::: "memory");
    __syncthreads();
    if (leader) {
        unsigned* bar = b.bar;
        __builtin_amdgcn_s_waitcnt(0);
        unsigned nloc = b.st[0], nx = b.st[1];
        if (nloc == 0u) { xcd_barrier_complete(bar, b.x, nloc, nx); b.st[0] = nloc; b.st[1] = nx; }
        const unsigned old = xb_add(&bar[XB_XSUB(b.x)], 1u);
        const unsigned gen = old / nloc;
        if (old + 1u == (gen + 1u) * nloc) {
            __builtin_amdgcn_fence(__ATOMIC_RELEASE, "agent");
            asm volatile("s_waitcnt vmcnt(0)" ::: "memory");
            const unsigned og = xb_add(&bar[XB_TOP], 1u);
            const unsigned tg = og / nx;
            if (og + 1u == (tg + 1u) * nx) xb_add(&bar[XB_TOPGEN], 1u);
            else XB_SPIN(xb_ld(&bar[XB_TOPGEN]) == tg, bar);
            __builtin_amdgcn_fence(__ATOMIC_ACQUIRE, "agent");
            xb_add(&bar[XB_XGEN(b.x)], 1u);
            asm volatile("s_waitcnt vmcnt(0)" ::: "memory");
        } else {
            XB_SPIN(xb_ld(&bar[XB_XGEN(b.x)]) == gen, bar);
            __builtin_amdgcn_fence(__ATOMIC_ACQUIRE, "agent");
            asm volatile("s_waitcnt vmcnt(0)" ::: "memory");
        }
    }
    __syncthreads();
}


#ifndef MK_STAG
#define MK_STAG 1
#endif
struct Args { P p; int ph_lo, ph_hi, flags, pad; };
#ifndef MK_USE_CG_SYNC
#define MK_USE_CG_SYNC 0
#endif
__global__ void __launch_bounds__(NTHREADS, 2) mk_fwd(Args args) {
    extern __shared__ __attribute__((aligned(16))) unsigned char lds_raw[];
#if MK_USE_CG_SYNC
    cg::grid_group grid = cg::this_grid();
#endif
    const P& p = args.p;
    Frame F; F.lds = (LAS unsigned char*)lds_raw; F.wave = __builtin_amdgcn_readfirstlane((int)threadIdx.x >> 6);
    F.G = gridDim.x; { const int bx = blockIdx.x; F.vcu = (F.G % 8 == 0) ? (bx % 8) * (F.G / 8) + bx / 8 : bx; }
    const int lo = args.ph_lo, hi = args.ph_hi; int ph = 0;
    volatile LAS unsigned* MISC = (volatile LAS unsigned*)(F.lds + RING_BYTES);
    if (F.wave == 0) MISC[lane_id()] = 0u;
    __syncthreads();
    const XcdBarrier xbar = xcd_barrier_post((unsigned*)(p.ws + WS_CTL) + 4096, MISC + 8, (F.wave == 0) && (lane_id() == 0));
#if MK_USE_CG_SYNC == 2
#define SEAM() do { if (ph >= lo && ph + 1 < hi) grid.sync(); ++ph; } while (0)
#else
#if MK_USE_CG_SYNC == 1
#define SEAM() do { if (ph >= lo && ph + 1 < hi) { if (ph == lo) grid.sync(); else xcd_barrier(xbar, (F.wave == 0) && (lane_id() == 0)); } ++ph; } while (0)
#else
#define SEAM() do { if (ph >= lo && ph + 1 < hi) xcd_barrier(xbar, (F.wave == 0) && (lane_id() == 0)); ++ph; } while (0)
#endif
#endif
#ifndef MK_GMASK
#define MK_GMASK 0xFFFFFFFFu
#endif
#define RUNG(g) (((MK_GMASK >> (g)) & 1u) && ph >= lo && ph < hi)
    using namespace pg8;
    bf16_t* const STb = (bf16_t*)p.out;
    const float* RF0 = WSP(float, WS_RF0);
    const int bx = blockIdx.x;
    if (RUNG(0)) phase_prologue(p, F);
    SEAM();
    for (int hf = 0; hf < 2; ++hf) {
        if (RUNG(1)) {
            { SchedDense<1024, 1024, 16> S; S.A = (const char*)(WSP(bf16_t, WS_XB) + (size_t)hf * HM * 1024); S.B = (const char*)WSP(bf16_t, WS_WRI); S.nM = 64; S.nN = 8; S.G = F.G; S.c = bx;
              EpiQK E{WSP(bf16_t, WS_QH), WSP(bf16_t, WS_KH), RF0, WSP(float, WS_COSR), WSP(float, WS_SINR), hf};
              gemm_phase(F.lds, F.wave, S, E); }
            { SchedDense<1024, 1024, 16> S; S.A = (const char*)(WSP(bf16_t, WS_WRI) + (size_t)1024 * 1024); S.B = (const char*)(WSP(bf16_t, WS_XB) + (size_t)hf * HM * 1024); S.nM = 12; S.nN = 64; S.G = F.G; S.c = bx;
              EpiKVT E{WSP(bf16_t, WS_KTF), WSP(bf16_t, WS_KTB), WSP(bf16_t, WS_VT), RF0, WSP(float, WS_COSRT), WSP(float, WS_SINRT), p.dfw, p.dbw, hf};
              gemm_phase(F.lds, F.wave, S, E); }
        }
        SEAM();
        if (RUNG(2)) {
            const int xl = F.vcu & 31, xg = F.vcu >> 5;
#ifndef MK_P2SEL
#define MK_P2SEL 3
#endif
            if (xl < 16) { if (MK_P2SEL & 1) {
                const int c = xg * 16 + xl, bh = c >> 2, dir = (c >> 1) & 1, dvh = c & 1, head = bh & 3;
                {
                    bf16_t* zt = STb + (size_t)((bh * 2 + dir) * 512 + dvh * 256) * 2048 + (dir ? 7 : 0) * 256;
                    for (int i = F.wave * 64 + lane_id(); i < 256 * 32; i += NTHREADS) *(u32x4*)(zt + (size_t)(i >> 5) * 2048 + (i & 31) * 8) = (u32x4){0u, 0u, 0u, 0u}; }
                SchedState S; S.VT = (const char*)WSP(bf16_t, WS_VT); S.KTF = (const char*)WSP(bf16_t, WS_KTF); S.KTB = (const char*)WSP(bf16_t, WS_KTB); S.c = c;
                S.gC = __builtin_amdgcn_exp2f(-__expf(dir ? p.dbw[head] : p.dfw[head]) * LOG2E * 256.f);
                EpiState E{STb};
                gemm_phase(F.lds, F.wave, S, E); }
            } else if (MK_P2SEL & 2) {
                SchedS S; S.QH = (const char*)WSP(bf16_t, WS_QH); S.KH = (const char*)WSP(bf16_t, WS_KH); S.c = xg * 16 + (xl - 16);
                EpiS E{WSP(bf16_t, WS_KH), p.dfw, p.dbw};
                gemm_phase(F.lds, F.wave, S, E);
                convert_late_weights(p, F, hf, S.c * NWAVES + F.wave, 128 * NWAVES);
            }
        }
        SEAM();
        if (RUNG(3)) {
            SchedR3 S; S.QH = (const char*)WSP(bf16_t, WS_QH); S.KH = (const char*)WSP(bf16_t, WS_KH); S.ST = (const char*)STb; S.VT = (const char*)WSP(bf16_t, WS_VT); S.dfw = p.dfw; S.dbw = p.dbw; S.c = F.vcu;
            EpiYZ E{WSP(bf16_t, WS_YZ), WSP(bf16_t, WS_YTMP) + (size_t)F.vcu * 65536, (LAS f32x2*)(F.lds + RING_BYTES + 1024), hf};
            { SchedG SG; SG.XBh = (const char*)(WSP(bf16_t, WS_XB) + (size_t)hf * HM * 1024); SG.WG = (const char*)(WSP(bf16_t, WS_WRI) + (size_t)4096 * 1024); SG.c = F.vcu;
              EpiG EG{WSP(bf16_t, WS_YZ), RF0, hf}; gemm_phase(F.lds, F.wave, SG, EG); }
            gemm_phase(F.lds, F.wave, S, E);
        }
        SEAM();
    }
    if (RUNG(5)) { SchedDense<2048, 2048, 32> S; S.A = (const char*)WSP(bf16_t, WS_YZ); S.B = (const char*)WSP(bf16_t, WS_WRO); S.nM = 128; S.nN = 4; S.G = F.G; S.c = bx;
        EpiRes<true> E{p.x, WSP(bf16_t, WS_XB), WSP(float, WS_SS)}; gemm_phase(F.lds, F.wave, S, E); }
    SEAM();
    if (RUNG(6)) { SchedDense<1024, 1024, 16> S; S.A = (const char*)WSP(bf16_t, WS_XB); S.B = (const char*)WSP(bf16_t, WS_W1A); S.nM = 128; S.nN = 16; S.G = F.G; S.c = bx;
        EpiFF E{WSP(bf16_t, WS_FF), WSP(float, WS_SS), args.flags}; gemm_phase(F.lds, F.wave, S, E, MK_STAG * (F.vcu & 3)); }
    SEAM();
    if (RUNG(7)) { SchedDense<4096, 4096, 64> S; S.A = (const char*)WSP(bf16_t, WS_FF); S.B = (const char*)WSP(bf16_t, WS_W2A); S.nM = 128; S.nN = 4; S.G = F.G; S.c = bx;
        EpiRes<false> E{nullptr, WSP(bf16_t, WS_XB), WSP(float, WS_SS) + (size_t)MTOK * 16}; gemm_phase(F.lds, F.wave, S, E); }
    SEAM();
    if (RUNG(8)) { SchedDense<1024, 1024, 16> S; S.A = (const char*)WSP(bf16_t, WS_XB); S.B = (const char*)WSP(bf16_t, WS_WAI); S.nM = 128; S.nN = 6; S.G = F.G; S.c = bx;
        EpiQKVfused E{WSP(bf16_t, WS_AQ), WSP(bf16_t, WS_AK), WSP(bf16_t, WS_AV), WSP(float, WS_SS) + (size_t)MTOK * 16, WSP(float, WS_COSA), WSP(float, WS_SINA), p.aqn, p.akn, (LAS float*)(F.lds + RING_BYTES + 1024)};
        gemm_phase(F.lds, F.wave, S, E); }
    SEAM();
    if (RUNG(10)) {
        for (int i = 0; i < 4; ++i) { const int L = F.vcu * 4 + i, b = L >> 6, kv = (L >> 5) & 1, qb = (L >> 2) & 7, g = L & 3, hq = kv * 4 + g;
            const size_t t0 = (size_t)b * 2048;
            att::attn_dense_body(WSP(bf16_t, WS_AQ) + (t0 + qb * 256) * 1024 + hq * 128, WSP(bf16_t, WS_AK) + t0 * 256 + kv * 128, WSP(bf16_t, WS_AV) + t0 * 256 + kv * 128,
                                 WSP(bf16_t, WS_AO) + (t0 + qb * 256) * 1024 + hq * 128, 2048, (char*)lds_raw, F.wave); }
    }
    SEAM();
    if (RUNG(11)) { SchedDense<1024, 1024, 16> S; S.A = (const char*)WSP(bf16_t, WS_AO); S.B = (const char*)WSP(bf16_t, WS_WAO); S.nM = 128; S.nN = 4; S.G = F.G; S.c = bx;
        EpiRes<false> E{nullptr, WSP(bf16_t, WS_XB), WSP(float, WS_SS) + 2 * (size_t)MTOK * 16}; gemm_phase(F.lds, F.wave, S, E); }
    SEAM();
    if (RUNG(12)) { SchedDense<1024, 1024, 16> S; S.A = (const char*)WSP(bf16_t, WS_XB); S.B = (const char*)WSP(bf16_t, WS_W1B); S.nM = 128; S.nN = 16; S.G = F.G; S.c = bx;
        EpiFF E{WSP(bf16_t, WS_FF), WSP(float, WS_SS) + 2 * (size_t)MTOK * 16, args.flags}; gemm_phase(F.lds, F.wave, S, E, MK_STAG * (F.vcu & 3)); }
    SEAM();
    if (RUNG(13)) { SchedDense<4096, 4096, 64> S; S.A = (const char*)WSP(bf16_t, WS_FF); S.B = (const char*)WSP(bf16_t, WS_W2B); S.nM = 128; S.nN = 4; S.G = F.G; S.c = bx;
        EpiRes<false> E{nullptr, WSP(bf16_t, WS_XB), WSP(float, WS_SS) + 3 * (size_t)MTOK * 16}; gemm_phase(F.lds, F.wave, S, E); }
    SEAM();
    if (RUNG(14)) phase_final(p, F, WSP(float, WS_SS) + 3 * (size_t)MTOK * 16);
#undef SEAM
#undef RUNG
}
constexpr int N_PHASES = 16;

static P make_p(void* const* d_in, void* d_out, void* d_ws) {
    P p{}; p.x = (const float*)d_in[0]; p.norm_mix = (const float*)d_in[1]; p.norm_mlp = (const float*)d_in[2]; p.w1 = (const float*)d_in[3]; p.w2 = (const float*)d_in[4];
    p.rwin = (const float*)d_in[5]; p.rwout = (const float*)d_in[6]; p.dfw = (const float*)d_in[7]; p.dbw = (const float*)d_in[8]; p.awin = (const float*)d_in[9]; p.awout = (const float*)d_in[10];
    p.aqn = (const float*)d_in[11]; p.akn = (const float*)d_in[12]; p.fnorm = (const float*)d_in[13]; p.out = (float*)d_out; p.ws = (unsigned char*)d_ws; return p;
}
static void mk_launch(const P& p, int ph_lo, int ph_hi, hipStream_t stream, int flags = 0) {
    static int grid = 0;
    if (grid == 0) {
        int dev = 0, cus = 0, per_cu = 0;
        (void)hipGetDevice(&dev); (void)hipDeviceGetAttribute(&cus, hipDeviceAttributeMultiprocessorCount, dev);
        if (hipFuncSetAttribute((const void*)mk_fwd, hipFuncAttributeMaxDynamicSharedMemorySize, LDS_BYTES) != hipSuccess) { fprintf(stderr, "hipFuncSetAttribute failed\n"); grid = -1; return; }
        if (hipOccupancyMaxActiveBlocksPerMultiprocessor(&per_cu, (const void*)mk_fwd, NTHREADS, LDS_BYTES) != hipSuccess || per_cu < 1) { fprintf(stderr, "occupancy query: %d blocks per CU\n", per_cu); grid = -1; return; }
        grid = cus;
        if (grid != 256) fprintf(stderr, "note: %d CUs (phase schedules assume 256)\n", grid);
    }
    if (grid < 0) return;
    (void)hipMemsetAsync(p.ws + WS_CTL + 4096 * 4, 0, XCD_BAR_WORDS * 4, stream);
    Args a{}; a.p = p; a.ph_lo = ph_lo; a.ph_hi = ph_hi; a.flags = flags;
    void* kargs[] = {&a};
#if MK_USE_CG_SYNC
    hipError_t e = hipLaunchCooperativeKernel((const void*)mk_fwd, dim3(grid), dim3(NTHREADS), kargs, LDS_BYTES, stream);
    if (e != hipSuccess) fprintf(stderr, "cooperative launch failed: %s (grid %d)\n", hipGetErrorString(e), grid);
#else
    (void)kargs; hipLaunchKernelGGL(mk_fwd, dim3(grid), dim3(NTHREADS), LDS_BYTES, stream, a);
    hipError_t e = hipPeekAtLastError(); if (e != hipSuccess) fprintf(stderr, "launch failed: %s (grid %d)\n", hipGetErrorString(e), grid);
#endif
}
extern "C" void kernel_launch(void* const* d_in, const int* in_sizes, int n_in, void* d_out, int out_size, void* d_ws, size_t ws_size, hipStream_t stream) {
    if (ws_size < WS_END) { fprintf(stderr, "kernel_launch: workspace too small (%zu < %zu)\n", ws_size, (size_t)WS_END); return; }
    const P p = make_p(d_in, d_out, d_ws);
    mk_launch(p, 0, N_PHASES, stream);
}
```

```cpp
#include <hip/hip_runtime.h>
#include <hip/hip_bf16.h>
#include <hip/hip_cooperative_groups.h>
#include <cstdio>
#include <cstdint>
namespace cg = cooperative_groups;

#define LAS __attribute__((address_space(3)))
#define GAS __attribute__((address_space(1)))
typedef unsigned short bf16_t;
typedef short bf16x8 __attribute__((ext_vector_type(8)));
typedef float f32x4 __attribute__((ext_vector_type(4)));
typedef float f32x2 __attribute__((ext_vector_type(2)));
typedef unsigned u32x4 __attribute__((ext_vector_type(4)));
typedef unsigned u32x2 __attribute__((ext_vector_type(2)));

constexpr int NB = 16, SEQ = 2048, DM = 1024, MTOK = NB * SEQ;
constexpr int HM = MTOK / 2;
constexpr float RMS_EPS = 1e-6f, GN_EPS = 1e-6f;
constexpr float LOG2E = 1.4426950408889634f;

__device__ __forceinline__ int lane_id() { return (int)__builtin_amdgcn_mbcnt_hi(~0u, __builtin_amdgcn_mbcnt_lo(~0u, 0u)); }
namespace pg8 {
constexpr int BM = 256, BK = 64, HALF = 128, HTB = HALF * BK * 2, STAGE_BYTES = 8 * HTB, NXCD = 8, WGM = 8;
__host__ __device__ __forceinline__ int lds_byte(int r, int c) { const int st = (r >> 4) * 2 + (c >> 5), rr = r & 15, cc = c & 31, ob = rr * 64 + cc * 2; return st * 1024 + (ob ^ (((ob >> 9) & 1) << 5)); }
__host__ __device__ __forceinline__ void stage_rc(int b, int& R, int& C) { const int st = b / 1024, sb = b % 1024, swz = sb ^ (((sb >> 9) & 1) << 5); R = (st >> 1) * 16 + swz / 64; C = (st & 1) * 32 + (swz % 64) / 2; }
__host__ __device__ __forceinline__ int perm32(int rho) { const int n = rho >> 4, i = rho & 15; return 8 * (i >> 2) + 4 * n + (i & 3); }

struct Unit { const char* a; const char* b; int pm, pn, aux; };

__device__ __forceinline__ void tile_of(int L, int nM, int nN, int& pm, int& pn) {
    const int nwg = nM * nN; int wgid = L; { const int q = nwg / NXCD, r = nwg % NXCD, xcd = wgid % NXCD, off = wgid / NXCD; wgid = (xcd < r ? xcd * (q + 1) : r * (q + 1) + (xcd - r) * q) + off; }
    const int nig = WGM * nN, gid = wgid / nig, fm = gid * WGM, gsz = (nM - fm) < WGM ? (nM - fm) : WGM;
    pm = fm + ((wgid % nig) % gsz); pn = (wgid % nig) / gsz;
}

__device__ __forceinline__ unsigned cvt_pk_bf16(float lo, float hi) { unsigned r; asm volatile("v_cvt_pk_bf16_f32 %0, %1, %2" : "=v"(r) : "v"(lo), "v"(hi)); return r; }
__device__ __forceinline__ float bf_lo(unsigned w) { return __uint_as_float(w << 16); }
__device__ __forceinline__ float bf_hi(unsigned w) { return __uint_as_float(w & 0xffff0000u); }

typedef f32x4 Acc[2][2][4][2];

template <class Epi, class Sched>
__device__ __forceinline__ void gemm_phase(LAS unsigned char* lds, int wave_id, const Sched& S, const Epi& E, int stagger = 0) {
    for (int i = 0; i < stagger; ++i) __builtin_amdgcn_s_sleep(127);
    int lane_ = lane_id(); asm volatile("" : "+v"(lane_));
    const int wid = wave_id, lane = lane_, tid = wid * 64 + lane, wr = wid >> 2, wc = wid & 3, fr = lane & 15, fq = lane >> 4;
    constexpr int LDA = Sched::LDA, LDB = Sched::LDB, nt = Sched::NT;
    unsigned voffA[2], voffB[2];
#pragma unroll
    for (int i = 0; i < 2; ++i) { int R, C; stage_rc(tid * 16 + i * 8192, R, C); const int Rb = (R & ~31) + perm32(R & 31);
        voffA[i] = (unsigned)(R * LDA + C) * 2u; voffB[i] = (unsigned)(Rb * LDB + C) * 2u; }
    constexpr size_t kstep = (size_t)(BK * 2);
    constexpr size_t hstepA = (size_t)HALF * LDA * 2, hstepB = (size_t)HALF * LDB * 2;
    const unsigned ldsw = (unsigned)wid * 1024u;
    const int aoff = lds_byte(wr * 64 + fr, fq * 8), boff = lds_byte(wc * 32 + fr, fq * 8);
#define PG8_SA(b, h) (((b) * 2 + (h)) * HTB)
#define PG8_SB(b, h) ((4 + (b) * 2 + (h)) * HTB)
#define PG8_STAGE(bufoff, gbase, voff) do { _Pragma("unroll") for (int _i = 0; _i < 2; ++_i) \
        __builtin_amdgcn_global_load_lds((const unsigned*)((const char*)(gbase) + (voff)[_i]), (LAS unsigned*)(lds + (bufoff) + ldsw + _i * 8192), 16, 0, 0); } while (0)
#define PG8_LDA(dst, b, h) do { _Pragma("unroll") for (int m = 0; m < 4; ++m) _Pragma("unroll") for (int k = 0; k < 2; ++k) dst[m][k] = *(const LAS bf16x8*)(lds + PG8_SA(b, h) + aoff + m * 2048 + k * 1024); } while (0)
#define PG8_LDB(dst, b, h) do { _Pragma("unroll") for (int n = 0; n < 2; ++n) _Pragma("unroll") for (int k = 0; k < 2; ++k) dst[n][k] = *(const LAS bf16x8*)(lds + PG8_SB(b, h) + boff + n * 2048 + k * 1024); } while (0)
#define PG8_MMA(ai, bj, At, Bt) do { __builtin_amdgcn_s_setprio(1); _Pragma("unroll") for (int m = 0; m < 4; ++m) _Pragma("unroll") for (int n = 0; n < 2; ++n) _Pragma("unroll") for (int k = 0; k < 2; ++k) \
        acc[ai][bj][m][n] = __builtin_amdgcn_mfma_f32_16x16x32_bf16(Bt[n][k], At[m][k], acc[ai][bj][m][n], 0, 0, 0); __builtin_amdgcn_s_setprio(0); } while (0)
#define PG8_WAIT_V(n) asm volatile("s_waitcnt vmcnt(" #n ")" ::: "memory")
#define PG8_WAIT_L(n) asm volatile("s_waitcnt lgkmcnt(" #n ")" ::: "memory")
#define PG8_BAR __builtin_amdgcn_s_barrier()
#define PG8_SCHED __builtin_amdgcn_sched_barrier(0)
    Unit cur, nxt; int ui = 0;
    if (!S.next(0, cur)) return;
    Acc acc;
    S.begin(acc, cur, 0, wr, fr);
    bf16x8 At[4][2], B0[2][2], B1[2][2];
    {
        const char* cA = S.ka(cur, 0); const char* cB = S.kb(cur, 0); const char* cA1 = S.ka(cur, 1); const char* cB1 = S.kb(cur, 1);
        PG8_STAGE(PG8_SB(0, 0), cB, voffB); PG8_STAGE(PG8_SB(0, 1), cB + hstepB, voffB); PG8_STAGE(PG8_SA(0, 0), cA, voffA); PG8_STAGE(PG8_SA(0, 1), cA + hstepA, voffA);
        if (wr == 1) PG8_BAR;
        PG8_WAIT_V(2); PG8_BAR;
        PG8_STAGE(PG8_SB(1, 0), cB1, voffB); PG8_STAGE(PG8_SA(1, 0), cA1, voffA); PG8_STAGE(PG8_SB(1, 1), cB1 + hstepB, voffB);
        PG8_WAIT_V(6); PG8_BAR;
    }
    for (;;) {
        const bool has_next = S.next(ui + 1, nxt);
        const Unit nx = has_next ? nxt : cur;
#pragma unroll 1
        for (int t = 0; t < nt; t += 2) {
            const bool last = (t == nt - 2);
            const char* a1 = S.ka(cur, t + 1);
            const char* a2 = last ? S.ka(nx, 0) : S.ka(cur, t + 2); const char* b2 = last ? S.kb(nx, 0) : S.kb(cur, t + 2);
            const char* a3 = last ? S.ka(nx, 1) : S.ka(cur, t + 3); const char* b3 = last ? S.kb(nx, 1) : S.kb(cur, t + 3);
            PG8_LDB(B0, 0, 0); PG8_LDB(B1, 0, 1); PG8_SCHED; PG8_LDA(At, 0, 0); PG8_STAGE(PG8_SA(1, 1), a1 + hstepA, voffA);
            PG8_WAIT_V(8); PG8_WAIT_L(0); PG8_BAR; PG8_MMA(0, 0, At, B0); PG8_MMA(0, 1, At, B1); PG8_BAR; PG8_SCHED;
            PG8_LDA(At, 0, 1); PG8_STAGE(PG8_SB(0, 0), b2, voffB); PG8_STAGE(PG8_SB(0, 1), b2 + hstepB, voffB); PG8_STAGE(PG8_SA(0, 0), a2, voffA);
            PG8_WAIT_V(8); PG8_WAIT_L(0); PG8_BAR; PG8_MMA(1, 0, At, B0); PG8_MMA(1, 1, At, B1); PG8_BAR; PG8_SCHED;
            PG8_LDB(B0, 1, 0); PG8_LDB(B1, 1, 1); PG8_SCHED; PG8_LDA(At, 1, 0); PG8_STAGE(PG8_SA(0, 1), a2 + hstepA, voffA);
            PG8_WAIT_V(8); PG8_WAIT_L(0); PG8_BAR; PG8_MMA(0, 0, At, B0); PG8_MMA(0, 1, At, B1); PG8_BAR; PG8_SCHED;
            PG8_LDA(At, 1, 1); PG8_STAGE(PG8_SB(1, 0), b3, voffB); PG8_STAGE(PG8_SB(1, 1), b3 + hstepB, voffB); PG8_STAGE(PG8_SA(1, 0), a3, voffA);
            PG8_WAIT_V(8); PG8_WAIT_L(0); PG8_BAR; PG8_MMA(1, 0, At, B0); PG8_MMA(1, 1, At, B1); PG8_BAR; PG8_SCHED;
            if constexpr (Sched::HAS_MID) S.mid(acc, cur, t + 2, wr, fr);
        }
        if (wr == 0) PG8_BAR;
        E(acc, cur, wr, wc, fr, fq);
        if (!has_next) break;
        ++ui; S.begin(acc, nxt, ui, wr, fr);
        cur = nxt;
        if (wr == 1) PG8_BAR;
    }
    PG8_WAIT_V(0);
    PG8_BAR;
#undef PG8_SA
#undef PG8_SB
#undef PG8_STAGE
#undef PG8_LDA
#undef PG8_LDB
#undef PG8_MMA
#undef PG8_WAIT_V
#undef PG8_WAIT_L
#undef PG8_BAR
#undef PG8_SCHED
}

__device__ __forceinline__ void acc_zero(Acc& acc) {
#pragma unroll
    for (int a = 0; a < 2; ++a)
#pragma unroll
        for (int b = 0; b < 2; ++b)
#pragma unroll
            for (int m = 0; m < 4; ++m)
#pragma unroll
                for (int n = 0; n < 2; ++n) acc[a][b][m][n] = (f32x4){0.f, 0.f, 0.f, 0.f};
}
}
constexpr size_t MiB = 1u << 20;
constexpr size_t WS_CTL = 0;
constexpr size_t WS_WRI = 1 * MiB, WS_WRO = 13 * MiB, WS_W1A = 17 * MiB, WS_W2A = 25 * MiB, WS_WAI = 33 * MiB, WS_WAO = 36 * MiB, WS_W1B = 38 * MiB, WS_W2B = 46 * MiB;
constexpr size_t WS_COSR = 54 * MiB, WS_SINR = 55 * MiB, WS_COSRT = 56 * MiB, WS_SINRT = 57 * MiB;
constexpr size_t WS_COSA = 58 * MiB, WS_SINA = 58 * MiB + 512 * 1024;
constexpr size_t WS_RF0 = 59 * MiB;
constexpr size_t WS_SS = 448 * MiB + 8 * MiB;
constexpr size_t WS_YTMP = 464 * MiB;
constexpr size_t WS_XB = 64 * MiB;
constexpr size_t WS_YZ = 128 * MiB;
constexpr size_t WS_QH = 256 * MiB, WS_KH = 288 * MiB, WS_KTF = 320 * MiB, WS_KTB = 352 * MiB, WS_VT = 384 * MiB;
constexpr size_t WS_FF = 128 * MiB;
constexpr size_t WS_AQ = 384 * MiB, WS_AK = 464 * MiB + 0, WS_AV = 480 * MiB, WS_AO = 128 * MiB;
constexpr size_t WS_END = 512 * MiB;
static_assert(WS_SS + 4ull * MTOK * 16 * 4 <= WS_AK, "SS fits below AK");

struct P {
    const float *x, *norm_mix, *norm_mlp, *w1, *w2, *rwin, *rwout, *dfw, *dbw, *awin, *awout, *aqn, *akn, *fnorm;
    float* out; unsigned char* ws;
};
#define WSP(T, off) ((T*)(p.ws + (off)))

namespace pg8 {
template <int LDA_, int LDB_, int NT_> struct SchedBase {
    static constexpr int LDA = LDA_, LDB = LDB_, NT = NT_; static constexpr bool HAS_MID = false;
    __device__ __forceinline__ const char* ka(const Unit& u, int t) const { return u.a + (size_t)t * 128; }
    __device__ __forceinline__ const char* kb(const Unit& u, int t) const { return u.b + (size_t)t * 128; }
    __device__ __forceinline__ void begin(Acc& acc, const Unit&, int, int, int) const { acc_zero(acc); }
    __device__ __forceinline__ void mid(Acc&, const Unit&, int, int, int) const {}
};
template <int LDA_, int LDB_, int NT_> struct SchedDense : SchedBase<LDA_, LDB_, NT_> {
    const char* A; const char* B; int nM, nN, G, c;
    __device__ __forceinline__ bool next(int i, Unit& u) const {
        const int L = i * G + c; if (L >= nM * nN) return false;
        int pm, pn; tile_of(L, nM, nN, pm, pn); u.pm = pm; u.pn = pn; u.aux = 0;
        u.a = A + (size_t)pm * 256 * LDA_ * 2; u.b = B + (size_t)pn * 256 * LDB_ * 2; return true; }
};
struct SchedS : SchedBase<1024, 1024, 4> {
    const char* QH; const char* KH; int c;
    __device__ __forceinline__ bool next(int i, Unit& u) const {
        if (i >= 2) return false; const int L = c * 2 + i, bh = L >> 3, ch = L & 7, bl = bh >> 2, head = bh & 3;
        const size_t off = ((size_t)(bl * 2048 + ch * 256) * 1024 + head * 256) * 2; u.a = QH + off; u.b = KH + off; u.pm = bh; u.pn = ch; u.aux = 0; return true; }
};
struct SchedState : SchedBase<2048, 2048, 4> {
    const char* VT; const char* KTF; const char* KTB; int c; float gC;
    __device__ __forceinline__ bool next(int i, Unit& u) const {
        if (i >= 7) return false; const int bh = c >> 2, dir = (c >> 1) & 1, dvh = c & 1, bl = bh >> 2, head = bh & 3;
        const int src = dir ? 7 - i : i, dest = dir ? 6 - i : i + 1;
        u.a = VT + ((size_t)(bl * 2048 + head * 512 + dvh * 256) * 2048 + src * 256) * 2;
        u.b = (dir ? KTB : KTF) + ((size_t)(bl * 1024 + head * 256) * 2048 + src * 256) * 2; u.pm = c; u.pn = dest; u.aux = 0; return true; }
    __device__ __forceinline__ void begin(Acc& acc, const Unit&, int i, int, int) const {
        if (i == 0) acc_zero(acc);
        else {
#pragma unroll
            for (int a = 0; a < 2; ++a)
#pragma unroll
                for (int b = 0; b < 2; ++b)
#pragma unroll
                    for (int m = 0; m < 4; ++m)
#pragma unroll
                        for (int n = 0; n < 2; ++n) acc[a][b][m][n] *= gC; } }
};
struct SchedR3 : SchedBase<1024, 2048, 12> {
    static constexpr bool HAS_MID = true;
    const char* QH; const char* KH; const char* ST; const char* VT; const float* dfw; const float* dbw; int c;
    __device__ __forceinline__ bool next(int i, Unit& u) const {
        if (i >= 2) return false; const int L = c * 2 + i, bh = L >> 4, ch = (L >> 1) & 7, dvh = L & 1, bl = bh >> 2, head = bh & 3;
        u.a = QH + ((size_t)(bl * 2048 + ch * 256) * 1024 + head * 256) * 2; u.b = nullptr; u.pm = bh; u.pn = ch; u.aux = dvh; return true; }
    __device__ __forceinline__ const char* ka(const Unit& u, int t) const { return u.a + (t >= 8 ? (KH - QH) : 0) + (size_t)(t & 3) * 128; }
    __device__ __forceinline__ const char* kb(const Unit& u, int t) const {
        const int bh = u.pm, ch = u.pn, dvh = u.aux, bl = bh >> 2, head = bh & 3;
        const char* base = (t >= 8) ? VT + ((size_t)(bl * 2048 + head * 512 + dvh * 256) * 2048 + ch * 256) * 2
                                    : ST + ((size_t)((bh * 2 + (t < 4 ? 1 : 0)) * 512 + dvh * 256) * 2048 + ch * 256) * 2;
        return base + (size_t)(t & 3) * 128; }
    __device__ __forceinline__ void mid(Acc& acc, const Unit& u, int tdone, int wr, int fr) const {
        if (tdone != 4 && tdone != 8) return;
        asm volatile("" : "+v"(fr));
        const int head = u.pm & 3; const float l2f = -__expf(dfw[head]) * LOG2E, l2b = -__expf(dbw[head]) * LOG2E;
#pragma unroll
        for (int a = 0; a < 2; ++a)
#pragma unroll
            for (int m = 0; m < 4; ++m) { const float i = (float)(a * 128 + wr * 64 + m * 16 + fr);
                const float f = (tdone == 4) ? __builtin_amdgcn_exp2f(l2b * (256.f - i) - l2f * (i + 1.f)) : __builtin_amdgcn_exp2f(l2f * (i + 1.f));
#pragma unroll
                for (int b = 0; b < 2; ++b)
#pragma unroll
                    for (int n = 0; n < 2; ++n) acc[a][b][m][n] *= f; } }
};

__device__ __forceinline__ u32x4 pack8(const f32x4& v0, const f32x4& v1) { u32x4 w; w.x = cvt_pk_bf16(v0[0], v0[1]); w.y = cvt_pk_bf16(v0[2], v0[3]); w.z = cvt_pk_bf16(v1[0], v1[1]); w.w = cvt_pk_bf16(v1[2], v1[3]); return w; }
__device__ __forceinline__ float rf_of(const float* ss16) {
    const f32x4 a = *(const f32x4*)ss16, b = *(const f32x4*)(ss16 + 4), c = *(const f32x4*)(ss16 + 8), d = *(const f32x4*)(ss16 + 12);
    const float s = ((a[0] + a[1]) + (a[2] + a[3])) + ((b[0] + b[1]) + (b[2] + b[3])) + ((c[0] + c[1]) + (c[2] + c[3])) + ((d[0] + d[1]) + (d[2] + d[3]));
    return rsqrtf(s * (1.0f / 1024.0f) + RMS_EPS); }

struct EpiQK {
    bf16_t* QH; bf16_t* KH; const float* RF0; const float* COSR; const float* SINR; int hf;
    __device__ __forceinline__ void operator()(const Acc& acc, const Unit& u, int wr, int wc, int fr, int fq) const {
        asm volatile("" : "+v"(fr), "+v"(fq));
        const int head = u.pn & 3; const bool isK = u.pn >= 4; const float osc = isK ? 0.0625f : 1.0f; bf16_t* base = (isK ? KH : QH) + head * 256; const int i0 = wc * 32 + fq * 8;
#pragma unroll
        for (int ai = 0; ai < 2; ++ai)
#pragma unroll
            for (int m = 0; m < 4; ++m) { const int tl = u.pm * 256 + ai * 128 + wr * 64 + m * 16 + fr, tg = hf * HM + tl, s = tg & 2047; const float r = RF0[tg] * osc;
                const f32x4 c0 = *(const f32x4*)(COSR + s * 128 + i0), c1 = *(const f32x4*)(COSR + s * 128 + i0 + 4), s0 = *(const f32x4*)(SINR + s * 128 + i0), s1 = *(const f32x4*)(SINR + s * 128 + i0 + 4);
                const f32x4 x10 = acc[ai][0][m][0] * r, x11 = acc[ai][0][m][1] * r, x20 = acc[ai][1][m][0] * r, x21 = acc[ai][1][m][1] * r;
                const f32x4 o10 = x10 * c0 - x20 * s0, o11 = x11 * c1 - x21 * s1, o20 = x10 * s0 + x20 * c0, o21 = x11 * s1 + x21 * c1;
                bf16_t* rp = base + (size_t)tl * 1024 + i0; *(u32x4*)rp = pack8(o10, o11); *(u32x4*)(rp + 128) = pack8(o20, o21); }
    }
};
struct EpiKVT {
    bf16_t* KTF; bf16_t* KTB; bf16_t* VT; const float* RF0; const float* COSRT; const float* SINRT; const float* dfw; const float* dbw; int hf;
    __device__ __forceinline__ void operator()(const Acc& acc, const Unit& u, int wr, int wc, int fr, int fq) const {
        asm volatile("" : "+v"(fr), "+v"(fq));
        if (u.pm < 4) {
            const int head = u.pm; const float l2f = -__expf(dfw[head]) * LOG2E, l2b = -__expf(dbw[head]) * LOG2E;
#pragma unroll
            for (int bj = 0; bj < 2; ++bj) { const int tl0 = u.pn * 256 + bj * 128 + wc * 32 + fq * 8, tg0 = hf * HM + tl0, s0 = tg0 & 2047, bl = tl0 >> 11, j0 = tl0 & 255;
                f32x4 r0 = *(const f32x4*)(RF0 + tg0) * 0.0625f, r1 = *(const f32x4*)(RF0 + tg0 + 4) * 0.0625f, zf0, zf1, zb0, zb1;
#pragma unroll
                for (int e = 0; e < 4; ++e) { zf0[e] = __builtin_amdgcn_exp2f(l2f * (float)(255 - j0 - e)); zf1[e] = __builtin_amdgcn_exp2f(l2f * (float)(251 - j0 - e));
                    zb0[e] = __builtin_amdgcn_exp2f(l2b * (float)(j0 + e)); zb1[e] = __builtin_amdgcn_exp2f(l2b * (float)(j0 + 4 + e)); }
#pragma unroll
                for (int m = 0; m < 4; ++m) { const int i = wr * 64 + m * 16 + fr;
                    const f32x4 c0 = *(const f32x4*)(COSRT + i * 2048 + s0), c1 = *(const f32x4*)(COSRT + i * 2048 + s0 + 4), sn0 = *(const f32x4*)(SINRT + i * 2048 + s0), sn1 = *(const f32x4*)(SINRT + i * 2048 + s0 + 4);
                    const f32x4 x10 = acc[0][bj][m][0] * r0, x11 = acc[0][bj][m][1] * r1, x20 = acc[1][bj][m][0] * r0, x21 = acc[1][bj][m][1] * r1;
                    const f32x4 o10 = x10 * c0 - x20 * sn0, o11 = x11 * c1 - x21 * sn1, o20 = x10 * sn0 + x20 * c0, o21 = x11 * sn1 + x21 * c1;
                    const size_t off = (size_t)(bl * 1024 + head * 256 + i) * 2048 + s0;
                    *(u32x4*)(KTF + off) = pack8(o10 * zf0, o11 * zf1); *(u32x4*)(KTF + off + 128 * 2048) = pack8(o20 * zf0, o21 * zf1);
                    *(u32x4*)(KTB + off) = pack8(o10 * zb0, o11 * zb1); *(u32x4*)(KTB + off + 128 * 2048) = pack8(o20 * zb0, o21 * zb1); } }
        } else {
            const int vrow0 = (u.pm - 4) * 256;
#pragma unroll
            for (int bj = 0; bj < 2; ++bj) { const int tl0 = u.pn * 256 + bj * 128 + wc * 32 + fq * 8, tg0 = hf * HM + tl0, s0 = tg0 & 2047, bl = tl0 >> 11;
                const f32x4 r0 = *(const f32x4*)(RF0 + tg0), r1 = *(const f32x4*)(RF0 + tg0 + 4);
#pragma unroll
                for (int ai = 0; ai < 2; ++ai)
#pragma unroll
                    for (int m = 0; m < 4; ++m) { const int f = vrow0 + ai * 128 + wr * 64 + m * 16 + fr;
                        *(u32x4*)(VT + (size_t)(bl * 2048 + f) * 2048 + s0) = pack8(acc[ai][bj][m][0] * r0, acc[ai][bj][m][1] * r1); } }
        }
    }
};
struct EpiS {
    bf16_t* KH; const float* dfw; const float* dbw;
    __device__ __forceinline__ void operator()(const Acc& acc, const Unit& u, int wr, int wc, int fr, int fq) const {
        asm volatile("" : "+v"(fr), "+v"(fq));
        const int bh = u.pm, ch = u.pn, bl = bh >> 2, head = bh & 3; const float l2f = -__expf(dfw[head]) * LOG2E, l2b = -__expf(dbw[head]) * LOG2E;
        bf16_t* base = KH + (size_t)(bl * 2048 + ch * 256) * 1024 + head * 256;
#pragma unroll
        for (int ai = 0; ai < 2; ++ai)
#pragma unroll
            for (int m = 0; m < 4; ++m) { const int i = ai * 128 + wr * 64 + m * 16 + fr;
#pragma unroll
                for (int bj = 0; bj < 2; ++bj) { const int j0 = bj * 128 + wc * 32 + fq * 8; f32x4 v0, v1; const float dd = (float)(i - j0);
#pragma unroll
                    for (int e = 0; e < 4; ++e) { const float d0 = dd - (float)e, d1 = dd - (float)(4 + e);
                        v0[e] = acc[ai][bj][m][0][e] * __builtin_amdgcn_exp2f(l2f * fmaxf(d0, 0.f) - l2b * fminf(d0, 0.f));
                        v1[e] = acc[ai][bj][m][1][e] * __builtin_amdgcn_exp2f(l2f * fmaxf(d1, 0.f) - l2b * fminf(d1, 0.f)); }
                    *(u32x4*)(base + (size_t)i * 1024 + j0) = pack8(v0, v1); } }
    }
};
struct EpiState {
    bf16_t* ST;
    __device__ __forceinline__ void operator()(const Acc& acc, const Unit& u, int wr, int wc, int fr, int fq) const {
        asm volatile("" : "+v"(fr), "+v"(fq));
        const int c = u.pm, bh = c >> 2, dir = (c >> 1) & 1, dvh = c & 1, dest = u.pn;
        bf16_t* base = ST + (size_t)((bh * 2 + dir) * 512 + dvh * 256) * 2048 + dest * 256;
#pragma unroll
        for (int ai = 0; ai < 2; ++ai)
#pragma unroll
            for (int m = 0; m < 4; ++m) { const int r = ai * 128 + wr * 64 + m * 16 + fr;
#pragma unroll
                for (int bj = 0; bj < 2; ++bj) *(u32x4*)(base + (size_t)r * 2048 + bj * 128 + wc * 32 + fq * 8) = pack8(acc[ai][bj][m][0], acc[ai][bj][m][1]); }
    }
};
struct SchedG : SchedBase<1024, 1024, 16> {
    const char* XBh; const char* WG; int c;
    __device__ __forceinline__ bool next(int i, Unit& u) const {
        if (i >= 2) return false; const int bh = c >> 3, ch = c & 7, bl = bh >> 2, head = bh & 3;
        u.a = XBh + (size_t)(bl * 2048 + ch * 256) * 1024 * 2; u.b = WG + (size_t)(head * 512 + i * 256) * 1024 * 2; u.pm = bh; u.pn = ch; u.aux = i; return true; }
};
struct EpiG {
    bf16_t* YZ; const float* RF0; int hf;
    __device__ __forceinline__ void operator()(const Acc& acc, const Unit& u, int wr, int wc, int fr, int fq) const {
        asm volatile("" : "+v"(fr), "+v"(fq));
        const int bh = u.pm, ch = u.pn, dvh = u.aux, bl = bh >> 2, head = bh & 3; const int tg0 = hf * HM + bl * 2048 + ch * 256;
#pragma unroll
        for (int ai = 0; ai < 2; ++ai)
#pragma unroll
            for (int m = 0; m < 4; ++m) { const int tg = tg0 + ai * 128 + wr * 64 + m * 16 + fr; const float r = RF0[tg];
#pragma unroll
                for (int bj = 0; bj < 2; ++bj) { f32x4 z0, z1;
#pragma unroll
                    for (int e = 0; e < 4; ++e) { const float g0 = acc[ai][bj][m][0][e] * r, g1 = acc[ai][bj][m][1][e] * r;
                        z0[e] = g0 * __builtin_amdgcn_rcpf(1.f + __expf(-g0)); z1[e] = g1 * __builtin_amdgcn_rcpf(1.f + __expf(-g1)); }
                    *(u32x4*)(YZ + (size_t)tg * 2048 + head * 512 + dvh * 256 + bj * 128 + wc * 32 + fq * 8) = pack8(z0, z1); } }
    }
};
__device__ __forceinline__ u32x4 ld_nt16(const bf16_t* p) { return __builtin_nontemporal_load((const u32x4*)p); }
struct EpiYZ {
    bf16_t* YZ; bf16_t* Ytmp; LAS f32x2* tab; int hf;
    __device__ __forceinline__ void operator()(const Acc& acc, const Unit& u, int wr, int wc, int fr, int fq) const {
        asm volatile("" : "+v"(fr), "+v"(fq));
        const int bh = u.pm, ch = u.pn, dvh = u.aux, bl = bh >> 2, head = bh & 3; const int tg0 = hf * HM + bl * 2048 + ch * 256;
#pragma unroll
        for (int ai = 0; ai < 2; ++ai)
#pragma unroll
            for (int m = 0; m < 4; ++m) { const int rl = ai * 128 + wr * 64 + m * 16 + fr; float s = 0.f, q = 0.f;
#pragma unroll
                for (int bj = 0; bj < 2; ++bj) { const f32x4 v0 = acc[ai][bj][m][0], v1 = acc[ai][bj][m][1];
                    s += ((v0[0] + v0[1]) + (v0[2] + v0[3])) + ((v1[0] + v1[1]) + (v1[2] + v1[3]));
                    q += ((v0[0] * v0[0] + v0[1] * v0[1]) + (v0[2] * v0[2] + v0[3] * v0[3])) + ((v1[0] * v1[0] + v1[1] * v1[1]) + (v1[2] * v1[2] + v1[3] * v1[3]));
                    if (dvh == 0) *(u32x4*)(Ytmp + (size_t)rl * 256 + bj * 128 + wc * 32 + fq * 8) = pack8(v0, v1); }
                s += __shfl_xor(s, 16); s += __shfl_xor(s, 32); q += __shfl_xor(q, 16); q += __shfl_xor(q, 32);
                if (fq == 0) tab[(dvh * 256 + rl) * 4 + wc] = (f32x2){s, q}; }
        if (dvh == 0) return;
        asm volatile("s_waitcnt lgkmcnt(0)" ::: "memory"); __builtin_amdgcn_s_barrier(); asm volatile("" ::: "memory");
#pragma unroll
        for (int ai = 0; ai < 2; ++ai)
#pragma unroll
            for (int m = 0; m < 4; ++m) { const int rl = ai * 128 + wr * 64 + m * 16 + fr, tg = tg0 + rl;
                const LAS f32x4* t0 = (const LAS f32x4*)(tab + rl * 4); const LAS f32x4* t1 = (const LAS f32x4*)(tab + (256 + rl) * 4);
                const f32x4 a = t0[0], b = t0[1], c = t1[0], d = t1[1];
                const float sm = (a[0] + a[2]) + (b[0] + b[2]) + (c[0] + c[2]) + (d[0] + d[2]), sq = (a[1] + a[3]) + (b[1] + b[3]) + (c[1] + c[3]) + (d[1] + d[3]);
                const float mu = sm * (1.f / 512.f), var = fmaxf(sq * (1.f / 512.f) - mu * mu, 0.f), rstd = rsqrtf(var + GN_EPS);
#pragma unroll
                for (int bj = 0; bj < 2; ++bj) { const int co = bj * 128 + wc * 32 + fq * 8; bf16_t* z1p = YZ + (size_t)tg * 2048 + head * 512 + 256 + co; bf16_t* z0p = z1p - 256;
                    const u32x4 g1 = ld_nt16(z1p), g0 = ld_nt16(z0p), y0 = ld_nt16(Ytmp + (size_t)rl * 256 + co); const f32x4 v0 = acc[ai][bj][m][0], v1 = acc[ai][bj][m][1];
                    const f32x4 ga = {bf_lo(g1.x), bf_hi(g1.x), bf_lo(g1.y), bf_hi(g1.y)}, gb = {bf_lo(g1.z), bf_hi(g1.z), bf_lo(g1.w), bf_hi(g1.w)};
                    *(u32x4*)z1p = pack8(ga * ((v0 - mu) * rstd), gb * ((v1 - mu) * rstd));
                    const f32x4 ha = {bf_lo(g0.x), bf_hi(g0.x), bf_lo(g0.y), bf_hi(g0.y)}, hb = {bf_lo(g0.z), bf_hi(g0.z), bf_lo(g0.w), bf_hi(g0.w)};
                    const f32x4 ya = {bf_lo(y0.x), bf_hi(y0.x), bf_lo(y0.y), bf_hi(y0.y)}, yb = {bf_lo(y0.z), bf_hi(y0.z), bf_lo(y0.w), bf_hi(y0.w)};
                    *(u32x4*)z0p = pack8(ha * ((ya - mu) * rstd), hb * ((yb - mu) * rstd)); } }
    }
};
template <bool FIRST> struct EpiRes {
    const float* xin; bf16_t* HB; float* SS;
    __device__ __forceinline__ void operator()(const Acc& acc, const Unit& u, int wr, int wc, int fr, int fq) const {
        asm volatile("" : "+v"(fr), "+v"(fq));
#pragma unroll
        for (int ai = 0; ai < 2; ++ai)
#pragma unroll
            for (int m = 0; m < 4; ++m) { const int tg = u.pm * 256 + ai * 128 + wr * 64 + m * 16 + fr; float q = 0.f;
#pragma unroll
                for (int bj = 0; bj < 2; ++bj) { const size_t off = (size_t)tg * 1024 + u.pn * 256 + bj * 128 + wc * 32 + fq * 8; f32x4 h0, h1;
                    if (FIRST) { h0 = *(const f32x4*)(xin + off) + acc[ai][bj][m][0]; h1 = *(const f32x4*)(xin + off + 4) + acc[ai][bj][m][1]; }
                    else { const u32x4 w = *(const u32x4*)(HB + off);
                        h0 = (f32x4){bf_lo(w.x), bf_hi(w.x), bf_lo(w.y), bf_hi(w.y)} + acc[ai][bj][m][0]; h1 = (f32x4){bf_lo(w.z), bf_hi(w.z), bf_lo(w.w), bf_hi(w.w)} + acc[ai][bj][m][1]; }
                    *(u32x4*)(HB + off) = pack8(h0, h1);
                    q += ((h0[0] * h0[0] + h0[1] * h0[1]) + (h0[2] * h0[2] + h0[3] * h0[3])) + ((h1[0] * h1[0] + h1[1] * h1[1]) + (h1[2] * h1[2] + h1[3] * h1[3])); }
                q += __shfl_xor(q, 16); q += __shfl_xor(q, 32);
                if (fq == 0) SS[(size_t)tg * 16 + u.pn * 4 + wc] = q; }
    }
};
struct EpiFF {
    bf16_t* FF; const float* SS; int flags;
    __device__ __forceinline__ void operator()(const Acc& acc, const Unit& u, int wr, int wc, int fr, int fq) const {
        if (flags & 4) { if (acc[0][0][0][0][0] == 1.2345e30f) FF[0] = 1; return; }
        asm volatile("" : "+v"(fr), "+v"(fq));
#pragma unroll
        for (int ai = 0; ai < 2; ++ai)
#pragma unroll
            for (int m = 0; m < 4; ++m) { const int tg = u.pm * 256 + ai * 128 + wr * 64 + m * 16 + fr; const float r = (flags & 2) ? 1.f : rf_of(SS + (size_t)tg * 16);
#pragma unroll
                for (int bj = 0; bj < 2; ++bj) { f32x4 v0 = acc[ai][bj][m][0] * r, v1 = acc[ai][bj][m][1] * r;
#pragma unroll
                    for (int e = 0; e < 4; ++e) { v0[e] = fmaxf(v0[e], 0.f); v1[e] = fmaxf(v1[e], 0.f); }
                    const u32x4 w = pack8(v0 * v0, v1 * v1);
                    if (!(flags & 1) || w.x == 0x12345678u) *(u32x4*)(FF + (size_t)tg * 4096 + u.pn * 256 + bj * 128 + wc * 32 + fq * 8) = w; } }
    }
};
struct EpiQKVfused {
    bf16_t* AQ; bf16_t* AK; bf16_t* AV; const float* SS; const float* COSA; const float* SINA; const float* qg; const float* kg; LAS float* xch;
    __device__ __forceinline__ void operator()(const Acc& acc, const Unit& u, int wr, int wc, int fr, int fq) const {
        asm volatile("" : "+v"(fr), "+v"(fq));
        if (u.pn == 5) {
#pragma unroll
            for (int ai = 0; ai < 2; ++ai)
#pragma unroll
                for (int m = 0; m < 4; ++m) { const int tg = u.pm * 256 + ai * 128 + wr * 64 + m * 16 + fr; const float r = rf_of(SS + (size_t)tg * 16);
#pragma unroll
                    for (int bj = 0; bj < 2; ++bj) *(u32x4*)(AV + (size_t)tg * 256 + bj * 128 + wc * 32 + fq * 8) = pack8(acc[ai][bj][m][0] * r, acc[ai][bj][m][1] * r); }
            asm volatile("s_waitcnt lgkmcnt(0)" ::: "memory"); __builtin_amdgcn_s_barrier(); asm volatile("" ::: "memory");
            return; }
        float rrow[2][4];
#pragma unroll
        for (int ai = 0; ai < 2; ++ai)
#pragma unroll
            for (int m = 0; m < 4; ++m) { const int rl = ai * 128 + wr * 64 + m * 16 + fr, tg = u.pm * 256 + rl; const float r = rf_of(SS + (size_t)tg * 16); rrow[ai][m] = r;
#pragma unroll
                for (int bj = 0; bj < 2; ++bj) { const f32x4 v0 = acc[ai][bj][m][0] * r, v1 = acc[ai][bj][m][1] * r;
                    float q = ((v0[0] * v0[0] + v0[1] * v0[1]) + (v0[2] * v0[2] + v0[3] * v0[3])) + ((v1[0] * v1[0] + v1[1] * v1[1]) + (v1[2] * v1[2] + v1[3] * v1[3]));
                    q += __shfl_xor(q, 16); q += __shfl_xor(q, 32);
                    if (fq == 0) xch[(rl * 2 + bj) * 4 + wc] = q; } }
        asm volatile("s_waitcnt lgkmcnt(0)" ::: "memory"); __builtin_amdgcn_s_barrier(); asm volatile("" ::: "memory");
        const bool isK = (u.pn == 4); const float* g = isK ? kg : qg; const int j0 = wc * 16 + fq * 4;
        const f32x4 g0 = *(const f32x4*)(g + j0), g1 = *(const f32x4*)(g + 64 + j0);
        bf16_t* dst = isK ? AK : AQ + u.pn * 256; const int ld = isK ? 256 : 1024;
#pragma unroll
        for (int ai = 0; ai < 2; ++ai)
#pragma unroll
            for (int m = 0; m < 4; ++m) { const int rl = ai * 128 + wr * 64 + m * 16 + fr, tg = u.pm * 256 + rl, sp = tg & 2047;
                const f32x4 c = *(const f32x4*)(COSA + sp * 64 + j0), sn = *(const f32x4*)(SINA + sp * 64 + j0);
#pragma unroll
                for (int bj = 0; bj < 2; ++bj) { const f32x4 pq = *(const LAS f32x4*)(xch + (rl * 2 + bj) * 4);
                    const float rn = rsqrtf(((pq[0] + pq[1]) + (pq[2] + pq[3])) * (1.f / 128.f) + RMS_EPS) * rrow[ai][m];
                    const f32x4 x1 = acc[ai][bj][m][0] * rn * g0, x2 = acc[ai][bj][m][1] * rn * g1;
                    *(u32x4*)(dst + (size_t)tg * ld + bj * 128 + wc * 32 + fq * 8) = pack8(x1 * c - x2 * sn, x1 * sn + x2 * c); } }
    }
};
}
namespace att {
constexpr int D = 128, NW = 8, QBLK = 32, KVBLK = 64;
constexpr float SCALE = 0.088388347648318440f;
constexpr float THR = 8.f;
constexpr int LDQ = 1024, LDK = 256, LDO = 1024;
constexpr size_t SHM_V = KVBLK * D * 2, SHM_K = KVBLK * D * 2, SHM_ATTN = 2 * SHM_V + 2 * SHM_K + NW * 64 * 4;
using s16x4 = __attribute__((ext_vector_type(4))) short;
using f32x16 = __attribute__((ext_vector_type(16))) float;
#define KSWZ(row, colB) ((row) * 256 + ((colB) ^ (((row) & 7) << 4)))
#define SBAR() __builtin_amdgcn_sched_barrier(0)
__device__ __forceinline__ int crow(int r, int hi) { return (r & 3) + 8 * (r >> 2) + 4 * hi; }
__device__ __forceinline__ unsigned cvtpk(float lo, float hi) { unsigned r; asm volatile("v_cvt_pk_bf16_f32 %0, %1, %2" : "=v"(r) : "v"(lo), "v"(hi)); return r; }
__device__ __forceinline__ void partialSM(f32x16& p0, f32x16& p1, float& m_reg, float& mn, float& alpha) {
  constexpr float C = SCALE * 1.4426950408889634f;
  float pmax = p0[0]; for (int r = 1; r < 16; ++r) pmax = fmaxf(pmax, p0[r]); for (int r = 0; r < 16; ++r) pmax = fmaxf(pmax, p1[r]);
  { auto rr = __builtin_amdgcn_permlane32_swap(__float_as_uint(pmax), __float_as_uint(pmax), false, false);
    pmax = fmaxf(__uint_as_float(rr[0]), __uint_as_float(rr[1])); }
  if (__builtin_expect(__all(pmax - m_reg <= THR / SCALE), 1)) { mn = m_reg; alpha = 1.f; }
  else { mn = fmaxf(m_reg, pmax); alpha = __builtin_amdgcn_exp2f((m_reg - mn) * C); m_reg = mn; }
  float mnC = -mn * C;
  for (int r = 0; r < 16; ++r) p0[r] = fmaf(p0[r], C, mnC); for (int r = 0; r < 16; ++r) p1[r] = fmaf(p1[r], C, mnC);
  for (int r = 0; r < 16; ++r) p0[r] = __builtin_amdgcn_exp2f(p0[r]);
}
__device__ __forceinline__ void finishSM(f32x16& p0, f32x16& p1, float alpha, float& l_reg, bf16x8& pa0, bf16x8& pa1, bf16x8& pa2, bf16x8& pa3) {
  for (int r = 0; r < 16; ++r) p1[r] = __builtin_amdgcn_exp2f(p1[r]);
  float ps = 0; for (int r = 0; r < 16; ++r) ps += p0[r]; for (int r = 0; r < 16; ++r) ps += p1[r];
  { auto rr = __builtin_amdgcn_permlane32_swap(__float_as_uint(ps), __float_as_uint(ps), false, false);
    ps = __uint_as_float(rr[0]) + __uint_as_float(rr[1]); }
  l_reg = l_reg * alpha + ps;
#define PK4(P, BASE, OUT) do { unsigned a0 = cvtpk(P[BASE + 0], P[BASE + 1]), a1 = cvtpk(P[BASE + 2], P[BASE + 3]);   \
    unsigned b0 = cvtpk(P[BASE + 4], P[BASE + 5]), b1 = cvtpk(P[BASE + 6], P[BASE + 7]);                              \
    auto r0 = __builtin_amdgcn_permlane32_swap(a0, b0, false, false); auto r1 = __builtin_amdgcn_permlane32_swap(a1, b1, false, false); \
    u32x4 w = {r0[0], r1[0], r0[1], r1[1]}; OUT = *reinterpret_cast<bf16x8*>(&w); } while (0)
  PK4(p0, 0, pa0); PK4(p0, 8, pa1); PK4(p1, 0, pa2); PK4(p1, 8, pa3);
#undef PK4
}
__device__ __forceinline__ void qkt(f32x16& p0, f32x16& p1, const bf16_t* Ks, const bf16x8* qr, int r32, int hi) {
  p0 = f32x16{}; p1 = f32x16{};
  for (int d0 = 0; d0 < 8; ++d0) { int cb = (d0 * 16 + hi * 8) * 2;
    bf16x8 b0 = *reinterpret_cast<const bf16x8*>((const char*)Ks + KSWZ(r32, cb));
    bf16x8 b1 = *reinterpret_cast<const bf16x8*>((const char*)Ks + KSWZ(32 + r32, cb));
    p0 = __builtin_amdgcn_mfma_f32_32x32x16_bf16(b0, qr[d0], p0, 0, 0, 0);
    p1 = __builtin_amdgcn_mfma_f32_32x32x16_bf16(b1, qr[d0], p1, 0, 0, 0); }
}
__device__ __forceinline__ int v_st(int k, int c) { const int kk = (k & ~0xC) | ((k & 4) << 1) | ((k & 8) >> 1); return ((kk >> 3) * 4 + (c >> 5)) * 512 + ((kk & 7) * 32 + (c & 31)) * 2; }
__device__ __forceinline__ int v_rd_base(int lane) { return ((lane & 3) << 3) | (((lane >> 2) & 3) << 6) | (((lane >> 4) & 1) << 5) | (((lane >> 5) & 1) << 8); }
constexpr int v_rd_off(int d0, int ks, int half) { return d0 * 512 + ks * 4096 + half * 2048; }
template <int OFF> __device__ __forceinline__ s16x4 tr_read(int vb) {
  s16x4 r; asm volatile("ds_read_b64_tr_b16 %0, %1 offset:%2" : "=&v"(r) : "v"(vb), "i"(OFF) : "memory"); return r;
}
template <int D0> __device__ __forceinline__ void pv_one(f32x16& od, int vb, bf16x8 pa0, bf16x8 pa1, bf16x8 pa2, bf16x8 pa3) {
  const s16x4 l0 = tr_read<v_rd_off(D0, 0, 0)>(vb), h0 = tr_read<v_rd_off(D0, 0, 1)>(vb), l1 = tr_read<v_rd_off(D0, 1, 0)>(vb), h1 = tr_read<v_rd_off(D0, 1, 1)>(vb);
  const s16x4 l2 = tr_read<v_rd_off(D0, 2, 0)>(vb), h2 = tr_read<v_rd_off(D0, 2, 1)>(vb), l3 = tr_read<v_rd_off(D0, 3, 0)>(vb), h3 = tr_read<v_rd_off(D0, 3, 1)>(vb);
  asm volatile("s_waitcnt lgkmcnt(0)" ::: "memory"); SBAR();
#define PK(L, H) (bf16x8){L[0], L[1], L[2], L[3], H[0], H[1], H[2], H[3]}
  od = __builtin_amdgcn_mfma_f32_32x32x16_bf16(pa0, PK(l0, h0), od, 0, 0, 0);
  od = __builtin_amdgcn_mfma_f32_32x32x16_bf16(pa1, PK(l1, h1), od, 0, 0, 0);
  od = __builtin_amdgcn_mfma_f32_32x32x16_bf16(pa2, PK(l2, h2), od, 0, 0, 0);
  od = __builtin_amdgcn_mfma_f32_32x32x16_bf16(pa3, PK(l3, h3), od, 0, 0, 0);
#undef PK
}
__device__ __forceinline__ void pv_d0(f32x16* o, int vb, bf16x8 pa0, bf16x8 pa1, bf16x8 pa2, bf16x8 pa3) {
  pv_one<0>(o[0], vb, pa0, pa1, pa2, pa3); pv_one<1>(o[1], vb, pa0, pa1, pa2, pa3); pv_one<2>(o[2], vb, pa0, pa1, pa2, pa3); pv_one<3>(o[3], vb, pa0, pa1, pa2, pa3);
}
__device__ __forceinline__ void attn_dense_body(const bf16_t* __restrict__ Qb, const bf16_t* __restrict__ Kh, const bf16_t* __restrict__ Vh, bf16_t* __restrict__ Ob, int seq, char* lds, int wave_id) {
  int tid = wave_id * 64 + lane_id(); asm volatile("" : "+v"(tid));
  const int wid = wave_id, lane = tid & 63, r32 = lane & 31, hi = lane >> 5;
  bf16_t* V_lds = (bf16_t*)lds; bf16_t* K_lds = (bf16_t*)(lds + 2 * SHM_V);
  float* ws = (float*)(lds + 2 * SHM_V + 2 * SHM_K) + wid * 64; float* li_l = ws; float* al_l = ws + 32;
  float m_reg = -1e30f, l_reg = 0; f32x16 o[4] = {}; bf16x8 qr[8];
  const bf16_t* Qw = Qb + (long)(wid * QBLK + r32) * LDQ + hi * 8;
#pragma unroll
  for (int d0 = 0; d0 < 8; ++d0) qr[d0] = *reinterpret_cast<const bf16x8*>(Qw + d0 * 16);
  const int sr = tid >> 4, sc = (tid & 15) * 8, vst0 = v_st(sr, sc), vst1 = v_st(32 + sr, sc);
  const int vb0 = (int)(uintptr_t)V_lds + v_rd_base(lane);
  struct { bf16x8 vs0, vs1, ks0, ks1; } sr_[2];
#define SLOAD(i, k0) do { sr_[i].vs0 = *reinterpret_cast<const bf16x8*>(&Vh[(long)((k0) + sr) * LDK + sc]); sr_[i].vs1 = *reinterpret_cast<const bf16x8*>(&Vh[(long)((k0) + 32 + sr) * LDK + sc]); \
    sr_[i].ks0 = *reinterpret_cast<const bf16x8*>(&Kh[(long)((k0) + sr) * LDK + sc]); sr_[i].ks1 = *reinterpret_cast<const bf16x8*>(&Kh[(long)((k0) + 32 + sr) * LDK + sc]); } while (0)
#define SWRITE(b, i) do { *(bf16x8*)((char*)V_lds + (b) * SHM_V + vst0) = sr_[i].vs0;          \
    *(bf16x8*)((char*)V_lds + (b) * SHM_V + vst1) = sr_[i].vs1; int kc = sc * 2;               \
    *(bf16x8*)((char*)K_lds + (b) * SHM_K + KSWZ(sr, kc)) = sr_[i].ks0;                       \
    *(bf16x8*)((char*)K_lds + (b) * SHM_K + KSWZ(32 + sr, kc)) = sr_[i].ks1; } while (0)
#define SWAIT() asm volatile("s_waitcnt vmcnt(4)" ::: "memory")
#define RESC(a) do { if (__any((a) < 1.f)) { if (hi == 0) al_l[r32] = (a); asm volatile("s_waitcnt lgkmcnt(0)" ::: "memory"); \
    for (int d = 0; d < 4; ++d) for (int r = 0; r < 16; ++r) o[d][r] *= al_l[crow(r, hi)]; } } while (0)
  f32x16 pA0, pA1, pB0, pB1; float mnA, mnB, alA, alB; bf16x8 pa0, pa1, pa2, pa3; const int NT = seq / KVBLK;
  constexpr int SE = 0, SO = 1;
  SLOAD(SE, 0); asm volatile("s_waitcnt vmcnt(0)" ::: "memory"); SWRITE(0, SE); __syncthreads();
  qkt(pA0, pA1, K_lds, qr, r32, hi); partialSM(pA0, pA1, m_reg, mnA, alA);
  SLOAD(SO, KVBLK); if (2 < NT) SLOAD(SE, 2 * KVBLK);
  SWAIT(); SWRITE(1, SO); __syncthreads();
  for (int j = 1; j + 1 < NT; j += 2) {
    SBAR(); qkt(pB0, pB1, (bf16_t*)((char*)K_lds + SHM_K), qr, r32, hi);
    finishSM(pA0, pA1, alA, l_reg, pa0, pa1, pa2, pa3); SBAR();
    SLOAD(SO, (j + 2) * KVBLK); SBAR();
    pv_d0(o, vb0, pa0, pa1, pa2, pa3); partialSM(pB0, pB1, m_reg, mnB, alB);
    __syncthreads(); SWAIT(); SWRITE(0, SE);
    RESC(alB); __syncthreads();
    SBAR(); qkt(pA0, pA1, K_lds, qr, r32, hi);
    finishSM(pB0, pB1, alB, l_reg, pa0, pa1, pa2, pa3); SBAR();
    if (j + 3 < NT) SLOAD(SE, (j + 3) * KVBLK); SBAR();
    pv_d0(o, vb0 + (int)SHM_V, pa0, pa1, pa2, pa3); partialSM(pA0, pA1, m_reg, mnA, alA);
    __syncthreads(); SWAIT(); SWRITE(1, SO);
    RESC(alA); __syncthreads();
  }
  SBAR(); qkt(pB0, pB1, (bf16_t*)((char*)K_lds + SHM_K), qr, r32, hi);
  finishSM(pA0, pA1, alA, l_reg, pa0, pa1, pa2, pa3); SBAR();
  pv_d0(o, vb0, pa0, pa1, pa2, pa3); partialSM(pB0, pB1, m_reg, mnB, alB);
  __syncthreads(); RESC(alB);
  finishSM(pB0, pB1, alB, l_reg, pa0, pa1, pa2, pa3); SBAR();
  pv_d0(o, vb0 + (int)SHM_V, pa0, pa1, pa2, pa3);
  if (hi == 0) li_l[r32] = l_reg; asm volatile("s_waitcnt lgkmcnt(0)" ::: "memory");
  __syncthreads();
  { bf16_t* stg = (bf16_t*)lds + wid * 4096;
#pragma unroll
    for (int r = 0; r < 16; ++r) { const int orow = crow(r, hi); const float rl = __builtin_amdgcn_rcpf(li_l[orow]);
#pragma unroll
      for (int d0 = 0; d0 < 4; ++d0) { const float v = o[d0][r] * rl; stg[orow * 128 + d0 * 32 + r32] = (bf16_t)(cvtpk(v, v) & 0xffffu); } }
    asm volatile("s_waitcnt lgkmcnt(0)" ::: "memory");
    bf16_t* Ow = Ob + (long)(wid * QBLK) * LDO;
#pragma unroll
    for (int i = 0; i < 8; ++i) { const int row = i * 4 + (lane >> 4), ch = lane & 15; const u32x4 v = *(const u32x4*)(stg + row * 128 + ch * 8); *(u32x4*)(Ow + (long)row * LDO + ch * 8) = v; } }
  __syncthreads();
#undef SLOAD
#undef SWRITE
#undef SWAIT
#undef RESC
}
#undef KSWZ
#undef SBAR
}
constexpr int NWAVES = 8, NTHREADS = 512;
constexpr int RING_BYTES = 131072, LDS_BYTES = 163840;
#define LDS_WAIT() asm volatile("s_waitcnt lgkmcnt(0)" ::: "memory")
#define VM_WAIT() asm volatile("s_waitcnt vmcnt(0)" ::: "memory")
__device__ __forceinline__ unsigned f2bf(float f) { unsigned u = __builtin_bit_cast(unsigned, f); return (u + 0x7fffu + ((u >> 16) & 1u)) >> 16; }
__device__ __forceinline__ unsigned pk2(float lo, float hi) { return f2bf(lo) | (f2bf(hi) << 16); }
__device__ __forceinline__ float wave_sum(float v) {
#pragma unroll
    for (int o = 1; o < 64; o <<= 1) v += __shfl_xor(v, o);
    return v;
}

struct Frame { LAS unsigned char* lds; int wave, vcu, G; };

__device__ __forceinline__ int qk_perm_row(int n) { if (n >= 1280) return n; const int d = n & 127, j = d & 63; return (n & ~127) + 8 * (j >> 2) + 4 * (d >> 6) + (j & 3); }
__device__ __forceinline__ void p0_transpose_item(const float* W, int K, int N, bf16_t* WT, const float* gain, LAS float* scr, int item, int lane, bool perm = false) {
    const int nblk = N / 32, kb = item / nblk, nb = item % nblk, k0 = 64 * kb, n0 = 32 * nb;
#pragma unroll 8
    for (int i = 0; i < 32; ++i) { const int kk = 2 * i + (lane >> 5); float v = W[(size_t)(k0 + kk) * N + n0 + (lane & 31)]; if (gain) v *= gain[k0 + kk]; scr[kk * 33 + (lane & 31)] = v; }
    LDS_WAIT(); asm volatile("" ::: "memory");
    const int c = lane & 7;
#pragma unroll
    for (int j = 0; j < 4; ++j) { const int n = (lane >> 3) + 8 * j; const LAS float* s = scr + (8 * c) * 33 + n;
        u32x4 o; o.x = pk2(s[0 * 33], s[1 * 33]); o.y = pk2(s[2 * 33], s[3 * 33]); o.z = pk2(s[4 * 33], s[5 * 33]); o.w = pk2(s[6 * 33], s[7 * 33]);
        *(u32x4*)(WT + (size_t)(perm ? qk_perm_row(n0 + n) : n0 + n) * K + k0 + 8 * c) = o; }
    LDS_WAIT(); asm volatile("" ::: "memory");
}
__device__ __forceinline__ void convert_late_weights(const P& p, Frame& F, int set, int slot, int nslots) {
    int lane = lane_id(); asm volatile("" : "+v"(lane));
    LAS float* scr = (LAS float*)(F.lds + F.wave * 16384);
    constexpr int I_RO = (2048 / 64) * (1024 / 32), I_1 = (1024 / 64) * (4096 / 32), I_2 = (4096 / 64) * (1024 / 32), I_AI = (1024 / 64) * (1536 / 32), I_AO = (1024 / 64) * (1024 / 32);
    if (set == 0) {
        for (int it = slot; it < I_RO + I_1 + I_2; it += nslots) { int r = it;
            if (r < I_RO) { p0_transpose_item(p.rwout, 2048, 1024, WSP(bf16_t, WS_WRO), nullptr, scr, r, lane); continue; } r -= I_RO;
            if (r < I_1) { p0_transpose_item(p.w1, 1024, 4096, WSP(bf16_t, WS_W1A), p.norm_mlp, scr, r, lane); continue; } r -= I_1;
            p0_transpose_item(p.w2, 4096, 1024, WSP(bf16_t, WS_W2A), nullptr, scr, r, lane); }
    } else {
        for (int it = slot; it < I_AI + I_AO + I_1 + I_2; it += nslots) { int r = it;
            if (r < I_AI) { p0_transpose_item(p.awin, 1024, 1536, WSP(bf16_t, WS_WAI), p.norm_mix + 1024, scr, r, lane, true); continue; } r -= I_AI;
            if (r < I_AO) { p0_transpose_item(p.awout, 1024, 1024, WSP(bf16_t, WS_WAO), nullptr, scr, r, lane); continue; } r -= I_AO;
            if (r < I_1) { p0_transpose_item(p.w1 + (size_t)1024 * 4096, 1024, 4096, WSP(bf16_t, WS_W1B), p.norm_mlp + 1024, scr, r, lane); continue; } r -= I_1;
            p0_transpose_item(p.w2 + (size_t)4096 * 1024, 4096, 1024, WSP(bf16_t, WS_W2B), nullptr, scr, r, lane); }
    }
}
__device__ __forceinline__ void phase_prologue(const P& p, Frame& F) {
    int lane = lane_id(); asm volatile("" : "+v"(lane)); const int tid = F.wave * 64 + lane;
    LAS float* scr = (LAS float*)(F.lds + F.wave * 16384);
    const int gw = F.vcu * NWAVES + F.wave, NGW = F.G * NWAVES;
    constexpr int I_RI = (1024 / 64) * (6144 / 32);
    for (int it = gw; it < I_RI; it += NGW) p0_transpose_item(p.rwin, 1024, 6144, WSP(bf16_t, WS_WRI), p.norm_mix, scr, it, lane);
    convert_late_weights(p, F, 0, gw, NGW); convert_late_weights(p, F, 1, gw, NGW);
    const int gt = F.vcu * NTHREADS + tid, NGT = F.G * NTHREADS;
    for (int idx = gt; idx < 2048 * 128; idx += NGT) { const int t = idx >> 7, i = idx & 127, f = i & 63; const float pos = (i < 64) ? (float)(t >> 6) : (float)(t & 63);
        const float ang = pos * powf(10000.0f, -(float)f * 2.0f / 128.0f); const float c = cosf(ang), s = sinf(ang);
        WSP(float, WS_COSR)[idx] = c; WSP(float, WS_SINR)[idx] = s; WSP(float, WS_COSRT)[i * 2048 + t] = c; WSP(float, WS_SINRT)[i * 2048 + t] = s; }
    for (int idx = gt; idx < 2048 * 64; idx += NGT) { const int t = idx >> 6, i = idx & 63, f = i & 31; const float pos = (i < 32) ? (float)(t >> 6) : (float)(t & 63);
        const float ang = pos * powf(10000.0f, -(float)f * 2.0f / 64.0f); WSP(float, WS_COSA)[idx] = cosf(ang); WSP(float, WS_SINA)[idx] = sinf(ang); }
    for (int m = gw; m < MTOK; m += NGW) {
        const f32x4* xr = (const f32x4*)(p.x + (size_t)m * 1024) + lane; f32x4 v[4]; float s = 0.f;
#pragma unroll
        for (int j = 0; j < 4; ++j) { v[j] = xr[64 * j]; s += (v[j].x * v[j].x + v[j].y * v[j].y) + (v[j].z * v[j].z + v[j].w * v[j].w); }
        s = wave_sum(s); if (lane == 0) WSP(float, WS_RF0)[m] = rsqrtf(s * (1.f / 1024.f) + RMS_EPS);
        unsigned long long* o8 = (unsigned long long*)(WSP(bf16_t, WS_XB) + (size_t)m * 1024) + lane;
#pragma unroll
        for (int j = 0; j < 4; ++j) o8[64 * j] = (unsigned long long)pk2(v[j].x, v[j].y) | ((unsigned long long)pk2(v[j].z, v[j].w) << 32);
    }
}
__device__ __forceinline__ void phase_qknorm(const P& p, Frame& F) {
    int lane = lane_id(); asm volatile("" : "+v"(lane));
    const int gw = F.vcu * NWAVES + F.wave, NGW = F.G * NWAVES; const int hl = lane & 31, hs = lane >> 5;
    const float* COSA = WSP(float, WS_COSA); const float* SINA = WSP(float, WS_SINA);
    for (int it = gw; it < MTOK * 5; it += NGW) { const int pr = it * 2 + hs, tg = pr / 10, hh = pr % 10;
        bf16_t* row = hh < 8 ? WSP(bf16_t, WS_AQ) + (size_t)tg * 1024 + hh * 128 : WSP(bf16_t, WS_AK) + (size_t)tg * 256 + (hh - 8) * 128; const float* g = hh < 8 ? p.aqn : p.akn;
        const unsigned w1 = *(const unsigned*)(row + 2 * hl), w2 = *(const unsigned*)(row + 64 + 2 * hl);
        float a0 = pg8::bf_lo(w1), a1 = pg8::bf_hi(w1), b0 = pg8::bf_lo(w2), b1 = pg8::bf_hi(w2); float s = (a0 * a0 + a1 * a1) + (b0 * b0 + b1 * b1);
#pragma unroll
        for (int o = 1; o < 32; o <<= 1) s += __shfl_xor(s, o);
        const float r = rsqrtf(s * (1.f / 128.f) + RMS_EPS); const f32x2 ga = *(const f32x2*)(g + 2 * hl), gb = *(const f32x2*)(g + 64 + 2 * hl);
        a0 *= r * ga.x; a1 *= r * ga.y; b0 *= r * gb.x; b1 *= r * gb.y;
        const int sp = tg & 2047; const f32x2 c = *(const f32x2*)(COSA + sp * 64 + 2 * hl), sn = *(const f32x2*)(SINA + sp * 64 + 2 * hl);
        *(unsigned*)(row + 2 * hl) = pk2(a0 * c.x - b0 * sn.x, a1 * c.y - b1 * sn.y); *(unsigned*)(row + 64 + 2 * hl) = pk2(a0 * sn.x + b0 * c.x, a1 * sn.y + b1 * c.y); }
}
__device__ __forceinline__ void phase_final(const P& p, Frame& F, const float* SS) {
    int lane = lane_id(); asm volatile("" : "+v"(lane));
    const int gw = F.vcu * NWAVES + F.wave, NGW = F.G * NWAVES;
    for (int m = gw; m < MTOK; m += NGW) { const float r = pg8::rf_of(SS + (size_t)m * 16); const u32x4* hr = (const u32x4*)(WSP(bf16_t, WS_XB) + (size_t)m * 1024) + lane; f32x4* orow = (f32x4*)(p.out + (size_t)m * 1024) + 2 * lane; const f32x4* gr = (const f32x4*)p.fnorm + 2 * lane;
#pragma unroll
        for (int j = 0; j < 2; ++j) { const u32x4 w = hr[64 * j];
            orow[128 * j] = (f32x4){pg8::bf_lo(w.x), pg8::bf_hi(w.x), pg8::bf_lo(w.y), pg8::bf_hi(w.y)} * r * gr[128 * j];
            orow[128 * j + 1] = (f32x4){pg8::bf_lo(w.z), pg8::bf_hi(w.z), pg8::bf_lo(w.w), pg8::bf_hi(w.w)} * r * gr[128 * j + 1]; } }
}

#define XB_TMO      128
#define XB_XCNT(j)  (256  + 64 * (j))
#define XB_XSUB(j)  (1280 + 64 * (j))
#define XB_XGEN(j)  (2304 + 64 * (j))
#define XB_TOP      3328
#define XB_TOPGEN   3392
#define XCD_BAR_WORDS 3456
#define XB_SPIN_CAP (1u << 22)
__device__ __forceinline__ unsigned xb_ld(unsigned* p)              { return __hip_atomic_load(p, __ATOMIC_RELAXED, __HIP_MEMORY_SCOPE_AGENT); }
__device__ __forceinline__ unsigned xb_add(unsigned* p, unsigned v) { return __hip_atomic_fetch_add(p, v, __ATOMIC_RELAXED, __HIP_MEMORY_SCOPE_AGENT); }
__device__ __forceinline__ unsigned xb_xcc_id() { return (unsigned)__builtin_amdgcn_s_getreg((3 << 11) | 20) & 0xFu; }
#define XB_SPIN(cond, bar) do { unsigned _sp = 0; while (cond) { __builtin_amdgcn_s_sleep(1); \
    if ((++_sp & 255u) == 0u) { if (xb_ld(&(bar)[XB_TMO])) break; if (_sp > XB_SPIN_CAP) { atomicAdd(&(bar)[XB_TMO], 1u); break; } } } } while (0)
struct XcdBarrier { unsigned* bar; unsigned x; volatile LAS unsigned* st; };
__device__ __forceinline__ XcdBarrier xcd_barrier_post(unsigned* bar, volatile LAS unsigned* st, bool leader) {
    XcdBarrier b; b.bar = bar; b.x = xb_xcc_id(); b.st = st;
    if (leader) (void)xb_add(&bar[XB_XCNT(b.x)], 1u);
    return b;
}
__device__ __forceinline__ void xcd_barrier_complete(unsigned* bar, unsigned x, unsigned& nloc, unsigned& nx) {
    const unsigned G = gridDim.x * gridDim.y * gridDim.z;
    unsigned sum, cnt, mine, sp = 0u;
    for (;;) {
        sum = 0u; cnt = 0u; mine = 0u;
#pragma unroll
        for (unsigned j = 0; j < 16; ++j) { const unsigned c = xb_ld(&bar[XB_XCNT(j)]); sum += c; cnt += (c > 0u) ? 1u : 0u; mine = (j == x) ? c : mine; }
        if (sum == G) break;
        __builtin_amdgcn_s_sleep(1);
        if ((++sp & 255u) == 0u) { if (xb_ld(&bar[XB_TMO])) break; if (sp > XB_SPIN_CAP) { atomicAdd(&bar[XB_TMO], 1u); break; } }
    }
    nloc = mine > 0u ? mine : 1u; nx = cnt > 0u ? cnt : 1u;
}
__device__ __forceinline__ void xcd_barrier(const XcdBarrier& b, bool leader) {
    asm volatile("s_waitcnt vmcnt(0)" ::: "memory");
    __syncthreads();
    if (leader) {
        unsigned* bar = b.bar;
        __builtin_amdgcn_s_waitcnt(0);
        unsigned nloc = b.st[0], nx = b.st[1];
        if (nloc == 0u) { xcd_barrier_complete(bar, b.x, nloc, nx); b.st[0] = nloc; b.st[1] = nx; }
        const unsigned old = xb_add(&bar[XB_XSUB(b.x)], 1u);
        const unsigned gen = old / nloc;
        if (old + 1u == (gen + 1u) * nloc) {
            __builtin_amdgcn_fence(__ATOMIC_RELEASE, "agent");
            asm volatile("s_waitcnt vmcnt(0)" ::: "memory");
            const unsigned og = xb_add(&bar[XB_TOP], 1u);
            const unsigned tg = og / nx;
            if (og + 1u == (tg + 1u) * nx) xb_add(&bar[XB_TOPGEN], 1u);
            else XB_SPIN(xb_ld(&bar[XB_TOPGEN]) == tg, bar);
            __builtin_amdgcn_fence(__ATOMIC_ACQUIRE, "agent");
            xb_add(&bar[XB_XGEN(b.x)], 1u);
            asm volatile("s_waitcnt vmcnt(0)" ::: "memory");
        } else {
            XB_SPIN(xb_ld(&bar[XB_XGEN(b.x)]) == gen, bar);
            __builtin_amdgcn_fence(__ATOMIC_ACQUIRE, "agent");
            asm volatile("s_waitcnt vmcnt(0)" ::: "memory");
        }
    }
    __syncthreads();
}


#ifndef MK_STAG
#define MK_STAG 1
#endif
struct Args { P p; int ph_lo, ph_hi, flags, pad; };
#ifndef MK_USE_CG_SYNC
#define MK_USE_CG_SYNC 0
#endif
__global__ void __launch_bounds__(NTHREADS, 2) mk_fwd(Args args) {
    extern __shared__ __attribute__((aligned(16))) unsigned char lds_raw[];
#if MK_USE_CG_SYNC
    cg::grid_group grid = cg::this_grid();
#endif
    const P& p = args.p;
    Frame F; F.lds = (LAS unsigned char*)lds_raw; F.wave = __builtin_amdgcn_readfirstlane((int)threadIdx.x >> 6);
    F.G = gridDim.x; { const int bx = blockIdx.x; F.vcu = (F.G % 8 == 0) ? (bx % 8) * (F.G / 8) + bx / 8 : bx; }
    const int lo = args.ph_lo, hi = args.ph_hi; int ph = 0;
    volatile LAS unsigned* MISC = (volatile LAS unsigned*)(F.lds + RING_BYTES);
    if (F.wave == 0) MISC[lane_id()] = 0u;
    __syncthreads();
    const XcdBarrier xbar = xcd_barrier_post((unsigned*)(p.ws + WS_CTL) + 4096, MISC + 8, (F.wave == 0) && (lane_id() == 0));
#if MK_USE_CG_SYNC == 2
#define SEAM() do { if (ph >= lo && ph + 1 < hi) grid.sync(); ++ph; } while (0)
#else
#if MK_USE_CG_SYNC == 1
#define SEAM() do { if (ph >= lo && ph + 1 < hi) { if (ph == lo) grid.sync(); else xcd_barrier(xbar, (F.wave == 0) && (lane_id() == 0)); } ++ph; } while (0)
#else
#define SEAM() do { if (ph >= lo && ph + 1 < hi) xcd_barrier(xbar, (F.wave == 0) && (lane_id() == 0)); ++ph; } while (0)
#endif
#endif
#ifndef MK_GMASK
#define MK_GMASK 0xFFFFFFFFu
#endif
#define RUNG(g) (((MK_GMASK >> (g)) & 1u) && ph >= lo && ph < hi)
    using namespace pg8;
    bf16_t* const STb = (bf16_t*)p.out;
    const float* RF0 = WSP(float, WS_RF0);
    const int bx = blockIdx.x;
    if (RUNG(0)) phase_prologue(p, F);
    SEAM();
    for (int hf = 0; hf < 2; ++hf) {
        if (RUNG(1)) {
            { SchedDense<1024, 1024, 16> S; S.A = (const char*)(WSP(bf16_t, WS_XB) + (size_t)hf * HM * 1024); S.B = (const char*)WSP(bf16_t, WS_WRI); S.nM = 64; S.nN = 8; S.G = F.G; S.c = bx;
              EpiQK E{WSP(bf16_t, WS_QH), WSP(bf16_t, WS_KH), RF0, WSP(float, WS_COSR), WSP(float, WS_SINR), hf};
              gemm_phase(F.lds, F.wave, S, E); }
            { SchedDense<1024, 1024, 16> S; S.A = (const char*)(WSP(bf16_t, WS_WRI) + (size_t)1024 * 1024); S.B = (const char*)(WSP(bf16_t, WS_XB) + (size_t)hf * HM * 1024); S.nM = 12; S.nN = 64; S.G = F.G; S.c = bx;
              EpiKVT E{WSP(bf16_t, WS_KTF), WSP(bf16_t, WS_KTB), WSP(bf16_t, WS_VT), RF0, WSP(float, WS_COSRT), WSP(float, WS_SINRT), p.dfw, p.dbw, hf};
              gemm_phase(F.lds, F.wave, S, E); }
        }
        SEAM();
        if (RUNG(2)) {
            const int xl = F.vcu & 31, xg = F.vcu >> 5;
#ifndef MK_P2SEL
#define MK_P2SEL 3
#endif
            if (xl < 16) { if (MK_P2SEL & 1) {
                const int c = xg * 16 + xl, bh = c >> 2, dir = (c >> 1) & 1, dvh = c & 1, head = bh & 3;
                {
                    bf16_t* zt = STb + (size_t)((bh * 2 + dir) * 512 + dvh * 256) * 2048 + (dir ? 7 : 0) * 256;
                    for (int i = F.wave * 64 + lane_id(); i < 256 * 32; i += NTHREADS) *(u32x4*)(zt + (size_t)(i >> 5) * 2048 + (i & 31) * 8) = (u32x4){0u, 0u, 0u, 0u}; }
                SchedState S; S.VT = (const char*)WSP(bf16_t, WS_VT); S.KTF = (const char*)WSP(bf16_t, WS_KTF); S.KTB = (const char*)WSP(bf16_t, WS_KTB); S.c = c;
                S.gC = __builtin_amdgcn_exp2f(-__expf(dir ? p.dbw[head] : p.dfw[head]) * LOG2E * 256.f);
                EpiState E{STb};
                gemm_phase(F.lds, F.wave, S, E); }
            } else if (MK_P2SEL & 2) {
                SchedS S; S.QH = (const char*)WSP(bf16_t, WS_QH); S.KH = (const char*)WSP(bf16_t, WS_KH); S.c = xg * 16 + (xl - 16);
                EpiS E{WSP(bf16_t, WS_KH), p.dfw, p.dbw};
                gemm_phase(F.lds, F.wave, S, E);
            }
        }
        SEAM();
        if (RUNG(3)) {
            SchedR3 S; S.QH = (const char*)WSP(bf16_t, WS_QH); S.KH = (const char*)WSP(bf16_t, WS_KH); S.ST = (const char*)STb; S.VT = (const char*)WSP(bf16_t, WS_VT); S.dfw = p.dfw; S.dbw = p.dbw; S.c = F.vcu;
            EpiYZ E{WSP(bf16_t, WS_YZ), WSP(bf16_t, WS_YTMP) + (size_t)F.vcu * 65536, (LAS f32x2*)(F.lds + RING_BYTES + 1024), hf};
            { SchedG SG; SG.XBh = (const char*)(WSP(bf16_t, WS_XB) + (size_t)hf * HM * 1024); SG.WG = (const char*)(WSP(bf16_t, WS_WRI) + (size_t)4096 * 1024); SG.c = F.vcu;
              EpiG EG{WSP(bf16_t, WS_YZ), RF0, hf}; gemm_phase(F.lds, F.wave, SG, EG); }
            gemm_phase(F.lds, F.wave, S, E);
        }
        SEAM();
    }
    if (RUNG(5)) { SchedDense<2048, 2048, 32> S; S.A = (const char*)WSP(bf16_t, WS_YZ); S.B = (const char*)WSP(bf16_t, WS_WRO); S.nM = 128; S.nN = 4; S.G = F.G; S.c = bx;
        EpiRes<true> E{p.x, WSP(bf16_t, WS_XB), WSP(float, WS_SS)}; gemm_phase(F.lds, F.wave, S, E); }
    SEAM();
    if (RUNG(6)) { SchedDense<1024, 1024, 16> S; S.A = (const char*)WSP(bf16_t, WS_XB); S.B = (const char*)WSP(bf16_t, WS_W1A); S.nM = 128; S.nN = 16; S.G = F.G; S.c = bx;
        EpiFF E{WSP(bf16_t, WS_FF), WSP(float, WS_SS), args.flags}; gemm_phase(F.lds, F.wave, S, E, MK_STAG * (F.vcu & 3)); }
    SEAM();
    if (RUNG(7)) { SchedDense<4096, 4096, 64> S; S.A = (const char*)WSP(bf16_t, WS_FF); S.B = (const char*)WSP(bf16_t, WS_W2A); S.nM = 128; S.nN = 4; S.G = F.G; S.c = bx;
        EpiRes<false> E{nullptr, WSP(bf16_t, WS_XB), WSP(float, WS_SS) + (size_t)MTOK * 16}; gemm_phase(F.lds, F.wave, S, E); }
    SEAM();
    if (RUNG(8)) { SchedDense<1024, 1024, 16> S; S.A = (const char*)WSP(bf16_t, WS_XB); S.B = (const char*)WSP(bf16_t, WS_WAI); S.nM = 128; S.nN = 6; S.G = F.G; S.c = bx;
        EpiQKVfused E{WSP(bf16_t, WS_AQ), WSP(bf16_t, WS_AK), WSP(bf16_t, WS_AV), WSP(float, WS_SS) + (size_t)MTOK * 16, WSP(float, WS_COSA), WSP(float, WS_SINA), p.aqn, p.akn, (LAS float*)(F.lds + RING_BYTES + 1024)};
        gemm_phase(F.lds, F.wave, S, E); }
    SEAM();
    if (RUNG(10)) {
        for (int i = 0; i < 4; ++i) { const int L = F.vcu * 4 + i, b = L >> 6, kv = (L >> 5) & 1, qb = (L >> 2) & 7, g = L & 3, hq = kv * 4 + g;
            const size_t t0 = (size_t)b * 2048;
            att::attn_dense_body(WSP(bf16_t, WS_AQ) + (t0 + qb * 256) * 1024 + hq * 128, WSP(bf16_t, WS_AK) + t0 * 256 + kv * 128, WSP(bf16_t, WS_AV) + t0 * 256 + kv * 128,
                                 WSP(bf16_t, WS_AO) + (t0 + qb * 256) * 1024 + hq * 128, 2048, (char*)lds_raw, F.wave); }
    }
    SEAM();
    if (RUNG(11)) { SchedDense<1024, 1024, 16> S; S.A = (const char*)WSP(bf16_t, WS_AO); S.B = (const char*)WSP(bf16_t, WS_WAO); S.nM = 128; S.nN = 4; S.G = F.G; S.c = bx;
        EpiRes<false> E{nullptr, WSP(bf16_t, WS_XB), WSP(float, WS_SS) + 2 * (size_t)MTOK * 16}; gemm_phase(F.lds, F.wave, S, E); }
    SEAM();
    if (RUNG(12)) { SchedDense<1024, 1024, 16> S; S.A = (const char*)WSP(bf16_t, WS_XB); S.B = (const char*)WSP(bf16_t, WS_W1B); S.nM = 128; S.nN = 16; S.G = F.G; S.c = bx;
        EpiFF E{WSP(bf16_t, WS_FF), WSP(float, WS_SS) + 2 * (size_t)MTOK * 16, args.flags}; gemm_phase(F.lds, F.wave, S, E, MK_STAG * (F.vcu & 3)); }
    SEAM();
    if (RUNG(13)) { SchedDense<4096, 4096, 64> S; S.A = (const char*)WSP(bf16_t, WS_FF); S.B = (const char*)WSP(bf16_t, WS_W2B); S.nM = 128; S.nN = 4; S.G = F.G; S.c = bx;
        EpiRes<false> E{nullptr, WSP(bf16_t, WS_XB), WSP(float, WS_SS) + 3 * (size_t)MTOK * 16}; gemm_phase(F.lds, F.wave, S, E); }
    SEAM();
    if (RUNG(14)) phase_final(p, F, WSP(float, WS_SS) + 3 * (size_t)MTOK * 16);
#undef SEAM
#undef RUNG
}
constexpr int N_PHASES = 16;

static P make_p(void* const* d_in, void* d_out, void* d_ws) {
    P p{}; p.x = (const float*)d_in[0]; p.norm_mix = (const float*)d_in[1]; p.norm_mlp = (const float*)d_in[2]; p.w1 = (const float*)d_in[3]; p.w2 = (const float*)d_in[4];
    p.rwin = (const float*)d_in[5]; p.rwout = (const float*)d_in[6]; p.dfw = (const float*)d_in[7]; p.dbw = (const float*)d_in[8]; p.awin = (const float*)d_in[9]; p.awout = (const float*)d_in[10];
    p.aqn = (const float*)d_in[11]; p.akn = (const float*)d_in[12]; p.fnorm = (const float*)d_in[13]; p.out = (float*)d_out; p.ws = (unsigned char*)d_ws; return p;
}
static void mk_launch(const P& p, int ph_lo, int ph_hi, hipStream_t stream, int flags = 0) {
    static int grid = 0;
    if (grid == 0) {
        int dev = 0, cus = 0, per_cu = 0;
        (void)hipGetDevice(&dev); (void)hipDeviceGetAttribute(&cus, hipDeviceAttributeMultiprocessorCount, dev);
        if (hipFuncSetAttribute((const void*)mk_fwd, hipFuncAttributeMaxDynamicSharedMemorySize, LDS_BYTES) != hipSuccess) { fprintf(stderr, "hipFuncSetAttribute failed\n"); grid = -1; return; }
        if (hipOccupancyMaxActiveBlocksPerMultiprocessor(&per_cu, (const void*)mk_fwd, NTHREADS, LDS_BYTES) != hipSuccess || per_cu < 1) { fprintf(stderr, "occupancy query: %d blocks per CU\n", per_cu); grid = -1; return; }
        grid = cus;
        if (grid != 256) fprintf(stderr, "note: %d CUs (phase schedules assume 256)\n", grid);
    }
    if (grid < 0) return;
    (void)hipMemsetAsync(p.ws + WS_CTL + 4096 * 4, 0, XCD_BAR_WORDS * 4, stream);
    Args a{}; a.p = p; a.ph_lo = ph_lo; a.ph_hi = ph_hi; a.flags = flags;
    void* kargs[] = {&a};
#if MK_USE_CG_SYNC
    hipError_t e = hipLaunchCooperativeKernel((const void*)mk_fwd, dim3(grid), dim3(NTHREADS), kargs, LDS_BYTES, stream);
    if (e != hipSuccess) fprintf(stderr, "cooperative launch failed: %s (grid %d)\n", hipGetErrorString(e), grid);
#else
    (void)kargs; hipLaunchKernelGGL(mk_fwd, dim3(grid), dim3(NTHREADS), LDS_BYTES, stream, a);
    hipError_t e = hipPeekAtLastError(); if (e != hipSuccess) fprintf(stderr, "launch failed: %s (grid %d)\n", hipGetErrorString(e), grid);
#endif
}
extern "C" void kernel_launch(void* const* d_in, const int* in_sizes, int n_in, void* d_out, int out_size, void* d_ws, size_t ws_size, hipStream_t stream) {
    if (ws_size < WS_END) { fprintf(stderr, "kernel_launch: workspace too small (%zu < %zu)\n", ws_size, (size_t)WS_END); return; }
    const P p = make_p(d_in, d_out, d_ws);
    mk_launch(p, 0, N_PHASES, stream);
}
```
